# Optimizing an MI355X kernel written in HIP

```python
import math
import jax, jax.numpy as jnp
from jax import lax
import numpy as np

D_MODEL = 2048
BATCH = 4
SEQ = 4096
DEPTH = 4

GRID_W = 64
CTX_LEN = 256
EPS = 1e-6
N_MIXERS = 2
N_S5 = (DEPTH + 1) // 2
N_ML = DEPTH // 2

S5_GROUP = 16
S5_GROUPS = D_MODEL // S5_GROUP
S5_STATE = 64
S5_DT_MIN = 1e-3
S5_DT_MAX = 1e-1

ML_HEADS = 8
ML_DV = D_MODEL // ML_HEADS
ML_DQK = ML_DV // 2
ML_CHUNK = 64
GATE_CAP = 15.0
ML_QK_W = ML_HEADS * ML_DQK
ML_V_W = ML_HEADS * ML_DV
ML_IN = 2 * ML_QK_W + 2 * ML_V_W + 4 * ML_HEADS
ML_SPLITS = (ML_QK_W, 2 * ML_QK_W, 2 * ML_QK_W + ML_V_W, 2 * ML_QK_W + 2 * ML_V_W)

FFN_HIDDEN = -(-8 * D_MODEL // (3 * 256)) * 256

kernel_name = "hybrid_s5_mlstm_dit_trunk"


def rmsnorm(x, g):
    xf = x.astype(jnp.float32)
    y = xf * lax.rsqrt(jnp.mean(xf * xf, axis=-1, keepdims=True) + EPS)
    return (y * g.astype(jnp.float32)).astype(x.dtype)


def modulate(x, shift, scale):
    return x * (1 + scale) + shift


def swiglu(u, w_in, w_out):
    gate, up = jnp.split(u @ w_in, 2, axis=-1)
    return (jax.nn.silu(gate) * up) @ w_out


def s5_discretize(lam_re, lam_im, log_dt, b_re, b_im):
    lam_re = lam_re.astype(jnp.float32)
    lam_im = lam_im.astype(jnp.float32)
    dt = jnp.exp(log_dt.astype(jnp.float32))[:, None]
    mag = jnp.exp(lam_re * dt)
    a_re = mag * jnp.cos(lam_im * dt)
    a_im = mag * jnp.sin(lam_im * dt)
    den = lam_re * lam_re + lam_im * lam_im
    f_re = ((a_re - 1.0) * lam_re + a_im * lam_im) / den
    f_im = (a_im * lam_re - (a_re - 1.0) * lam_im) / den
    b_re = b_re.astype(jnp.float32)
    b_im = b_im.astype(jnp.float32)
    bb_re = f_re[..., None] * b_re - f_im[..., None] * b_im
    bb_im = f_re[..., None] * b_im + f_im[..., None] * b_re
    return a_re, a_im, bb_re, bb_im


def _complex_affine_combine(e1, e2):
    a1r, a1i, b1r, b1i = e1
    a2r, a2i, b2r, b2i = e2
    return (a2r * a1r - a2i * a1i,
            a2r * a1i + a2i * a1r,
            a2r * b1r - a2i * b1i + b2r,
            a2r * b1i + a2i * b1r + b2i)


def s5_scan(a_re, a_im, bu_re, bu_im, h0, reverse):
    seq = bu_re.shape[0]
    if h0 is not None:
        h0_re, h0_im = h0
        first = seq - 1 if reverse else 0
        bu_re = bu_re.at[first].add(a_re * h0_re - a_im * h0_im)
        bu_im = bu_im.at[first].add(a_re * h0_im + a_im * h0_re)
    ar = jnp.broadcast_to(a_re, (seq, 1) + a_re.shape)
    ai = jnp.broadcast_to(a_im, (seq, 1) + a_im.shape)
    _, _, h_re, h_im = lax.associative_scan(_complex_affine_combine, (ar, ai, bu_re, bu_im),
                                            reverse=reverse, axis=0)
    return h_re, h_im


def s5_readout(h_re, h_im, c_re, c_im):
    return (jnp.einsum('lbgp,gcp->blgc', h_re, c_re) - jnp.einsum('lbgp,gcp->blgc', h_im, c_im))


def s5_mixer(u_lat, u_ctx, lam_re, lam_im, log_dt, b_re, b_im, c_re, c_im, d_skip, w_glu, with_ctx_out):
    bsz, seq, dm = u_lat.shape
    ctx_len = u_ctx.shape[1]
    ul = u_lat.astype(jnp.float32)
    uc = u_ctx.astype(jnp.float32)
    ul_g = ul.reshape(bsz, seq, S5_GROUPS, S5_GROUP)
    uc_g = uc.reshape(bsz, ctx_len, S5_GROUPS, S5_GROUP)
    dsk = d_skip.astype(jnp.float32)
    y_lat = ul * dsk
    y_ctx = uc * dsk if with_ctx_out else None
    for d in range(2):
        rev = d == 1
        a_re, a_im, bb_re, bb_im = s5_discretize(lam_re[d], lam_im[d], log_dt[d], b_re[d], b_im[d])
        cr = c_re[d].astype(jnp.float32)
        ci = c_im[d].astype(jnp.float32)
        hc_re, hc_im = s5_scan(a_re, a_im,
                               jnp.einsum('blgc,gpc->lbgp', uc_g, bb_re),
                               jnp.einsum('blgc,gpc->lbgp', uc_g, bb_im), None, rev)
        end = 0 if rev else -1
        h0 = (hc_re[end], hc_im[end])
        hl_re, hl_im = s5_scan(a_re, a_im,
                               jnp.einsum('blgc,gpc->lbgp', ul_g, bb_re),
                               jnp.einsum('blgc,gpc->lbgp', ul_g, bb_im), h0, rev)
        y_lat = y_lat + s5_readout(hl_re, hl_im, cr, ci).reshape(bsz, seq, dm)
        if with_ctx_out:
            y_ctx = y_ctx + s5_readout(hc_re, hc_im, cr, ci).reshape(bsz, ctx_len, dm)

    def glu(y):
        a, b = jnp.split(jax.nn.gelu(y.astype(u_lat.dtype)) @ w_glu, 2, axis=-1)
        return a * jax.nn.sigmoid(b)

    if with_ctx_out:
        out = glu(jnp.concatenate([y_ctx, y_lat], axis=1))
        return out[:, ctx_len:], out[:, :ctx_len]
    return glu(y_lat), None


def mlstm_chunk_scan(q, k, v, log_i, log_f, state):
    bsz, nh, seq, dk = q.shape
    dv = v.shape[-1]
    nc = seq // ML_CHUNK

    def chunks(t):
        return jnp.moveaxis(t.reshape((bsz, nh, nc, ML_CHUNK) + t.shape[3:]), 2, 0)

    lower = jnp.tril(jnp.ones((ML_CHUNK, ML_CHUNK), dtype=bool))

    def step(carry, xs):
        c_mat, n_vec, m = carry
        qb, kb, vb, li, lf = xs
        b = jnp.cumsum(lf, axis=-1)
        dmat = jnp.where(lower, b[..., :, None] - b[..., None, :] + li[..., None, :], -jnp.inf)
        inter = b + m[..., None]
        m_t = jnp.maximum(inter, jnp.max(dmat, axis=-1))
        w_intra = jnp.exp(dmat - m_t[..., None])
        w_inter = jnp.exp(inter - m_t)
        s = jnp.einsum('bhtd,bhsd->bhts', qb, kb) * w_intra
        num = (w_inter[..., None] * jnp.einsum('bhtd,bhde->bhte', qb, c_mat)
               + jnp.einsum('bhts,bhse->bhte', s, vb))
        den = w_inter * jnp.einsum('bhtd,bhd->bht', qb, n_vec) + jnp.sum(s, axis=-1)
        h = num / jnp.maximum(jnp.abs(den), jnp.exp(-m_t))[..., None]
        b_last = b[..., -1]
        g = b_last[..., None] - b + li
        m_new = jnp.maximum(b_last + m, jnp.max(g, axis=-1))
        wg = jnp.exp(g - m_new[..., None])
        decay = jnp.exp(b_last + m - m_new)
        c_new = decay[..., None, None] * c_mat + jnp.einsum('bhs,bhsd,bhse->bhde', wg, kb, vb)
        n_new = decay[..., None] * n_vec + jnp.einsum('bhs,bhsd->bhd', wg, kb)
        return (c_new, n_new, m_new), h

    state, h = lax.scan(step, state, tuple(chunks(t) for t in (q, k, v, log_i, log_f)))
    h = jnp.moveaxis(h, 0, 2).reshape(bsz, nh, seq, dv)
    return h, state


def mlstm_mixer(u_lat, u_ctx, w_in, b_gates, norm_w, w_out, with_ctx_out):
    bsz, seq, dm = u_lat.shape
    ctx_len = u_ctx.shape[1]
    rows = seq // GRID_W
    u_lat_cm = u_lat.reshape(bsz, rows, GRID_W, dm).transpose(0, 2, 1, 3).reshape(bsz, seq, dm)
    z = jnp.concatenate([u_ctx, u_lat_cm], axis=1) @ w_in
    q, k, v, o, g = jnp.split(z, ML_SPLITS, axis=-1)

    def heads(t, dh):
        return t.reshape(bsz, -1, ML_HEADS, dh).transpose(0, 2, 1, 3).astype(jnp.float32)

    q = heads(q, ML_DQK) * (ML_DQK ** -0.5)
    k = heads(k, ML_DQK)
    v = heads(v, ML_DV)
    g = g.astype(jnp.float32) + b_gates.astype(jnp.float32)
    g = GATE_CAP * jnp.tanh(g / GATE_CAP)
    g = g.reshape(bsz, -1, 4, ML_HEADS).transpose(2, 0, 3, 1)
    zero_state = (jnp.zeros((bsz, ML_HEADS, ML_DQK, ML_DV), jnp.float32),
                  jnp.zeros((bsz, ML_HEADS, ML_DQK), jnp.float32),
                  jnp.zeros((bsz, ML_HEADS), jnp.float32))
    h_lat = []
    h_ctx = []
    for d in range(2):
        flip = d == 1
        log_i = g[2 * d]
        log_f = jax.nn.log_sigmoid(g[2 * d + 1])
        seqs = (q, k, v, log_i, log_f)
        args_c = [t[:, :, :ctx_len] for t in seqs]
        args_l = [t[:, :, ctx_len:] for t in seqs]
        if flip:
            args_c = [jnp.flip(t, 2) for t in args_c]
            args_l = [jnp.flip(t, 2) for t in args_l]
        hc, st = mlstm_chunk_scan(*args_c, zero_state)
        hl, _ = mlstm_chunk_scan(*args_l, st)
        h_lat.append(jnp.flip(hl, 2) if flip else hl)
        if with_ctx_out:
            h_ctx.append(jnp.flip(hc, 2) if flip else hc)

    def readout(h, o_part):
        hn = h * lax.rsqrt(jnp.mean(h * h, axis=-1, keepdims=True) + EPS)
        hn = hn.transpose(0, 2, 1, 3).reshape(bsz, -1, dm) * norm_w.astype(jnp.float32)
        return (hn * jax.nn.sigmoid(o_part.astype(jnp.float32))).astype(u_lat.dtype) @ w_out

    y_lat = readout(h_lat[0] + h_lat[1], o[:, ctx_len:])
    y_lat = y_lat.reshape(bsz, GRID_W, rows, dm).transpose(0, 2, 1, 3).reshape(bsz, seq, dm)
    y_ctx = readout(h_ctx[0] + h_ctx[1], o[:, :ctx_len]) if with_ctx_out else None
    return y_lat, y_ctx


def setup_inputs(seed: int = 0) -> dict:
    key = jax.random.key(seed)
    ks = jax.random.split(key, 24)
    f32 = jnp.float32
    nrm = lambda k, shape, s: (jax.random.normal(k, shape, f32) * s)
    G, P, H = S5_GROUPS, S5_STATE, ML_HEADS
    lam_im_base = jnp.pi * jnp.arange(P, dtype=f32)
    f_bias = jnp.linspace(3.0, 6.0, H, dtype=f32)
    z_h = jnp.zeros((H,), f32)
    gate_base = jnp.concatenate([z_h, f_bias, z_h, f_bias])
    return {
        "x": nrm(ks[0], (BATCH, SEQ, D_MODEL), 1.0),
        "c": nrm(ks[1], (BATCH, D_MODEL), 1.0),
        "ctx": nrm(ks[2], (BATCH, CTX_LEN, D_MODEL), 1.0),
        "c_ctx": nrm(ks[3], (D_MODEL,), 1.0),
        "ada_w": nrm(ks[4], (DEPTH, D_MODEL, 6 * D_MODEL), 0.5 * D_MODEL ** -0.5),
        "ada_b": nrm(ks[5], (DEPTH, 6 * D_MODEL), 0.01),
        "norm1": 1.0 + nrm(ks[6], (DEPTH, D_MODEL), 0.02),
        "norm2": 1.0 + nrm(ks[7], (DEPTH, D_MODEL), 0.02),
        "norm_f": 1.0 + nrm(ks[8], (D_MODEL,), 0.02),
        "s5_lam_re": -0.5 + nrm(ks[9], (N_S5, 2, G, P), 0.01),
        "s5_lam_im": lam_im_base + nrm(ks[10], (N_S5, 2, G, P), 0.01),
        "s5_log_dt": jax.random.uniform(ks[11], (N_S5, 2, G), f32,
                                        minval=math.log(S5_DT_MIN), maxval=math.log(S5_DT_MAX)),
        "s5_b_re": nrm(ks[12], (N_S5, 2, G, P, S5_GROUP), (2 * S5_GROUP) ** -0.5),
        "s5_b_im": nrm(ks[13], (N_S5, 2, G, P, S5_GROUP), (2 * S5_GROUP) ** -0.5),
        "s5_c_re": nrm(ks[14], (N_S5, 2, G, S5_GROUP, P), (2 * P) ** -0.5),
        "s5_c_im": nrm(ks[15], (N_S5, 2, G, S5_GROUP, P), (2 * P) ** -0.5),
        "s5_d": nrm(ks[16], (N_S5, D_MODEL), 1.0),
        "s5_w_glu": nrm(ks[17], (N_S5, D_MODEL, 2 * D_MODEL), D_MODEL ** -0.5),
        "ml_w_in": nrm(ks[18], (N_ML, D_MODEL, ML_IN), D_MODEL ** -0.5),
        "ml_b_gates": gate_base + nrm(ks[19], (N_ML, 4 * H), 0.01),
        "ml_norm": 1.0 + nrm(ks[20], (N_ML, D_MODEL), 0.02),
        "ml_w_out": nrm(ks[21], (N_ML, D_MODEL, D_MODEL), D_MODEL ** -0.5),
        "ffn_w_in": nrm(ks[22], (DEPTH, D_MODEL, 2 * FFN_HIDDEN), D_MODEL ** -0.5),
        "ffn_w_out": nrm(ks[23], (DEPTH, FFN_HIDDEN, D_MODEL), FFN_HIDDEN ** -0.5),
    }


def reference(x, c, ctx, c_ctx, ada_w, ada_b, norm1, norm2, norm_f,
              s5_lam_re, s5_lam_im, s5_log_dt, s5_b_re, s5_b_im, s5_c_re, s5_c_im, s5_d, s5_w_glu,
              ml_w_in, ml_b_gates, ml_norm, ml_w_out, ffn_w_in, ffn_w_out):
    ctx_len = ctx.shape[1]
    cond_lat = jax.nn.silu(c)
    cond_ctx = jax.nn.silu(c_ctx)
    for i in range(DEPTH):
        last = i == DEPTH - 1
        j = i // N_MIXERS
        mod_l = jnp.split((cond_lat @ ada_w[i] + ada_b[i])[:, None, :], 6, axis=-1)
        mod_c = jnp.split(cond_ctx @ ada_w[i] + ada_b[i], 6, axis=-1)
        u_l = modulate(rmsnorm(x, norm1[i]), mod_l[0], mod_l[1])
        u_c = modulate(rmsnorm(ctx, norm1[i]), mod_c[0], mod_c[1])
        if i % N_MIXERS == 0:
            y_l, y_c = s5_mixer(u_l, u_c, s5_lam_re[j], s5_lam_im[j], s5_log_dt[j], s5_b_re[j], s5_b_im[j],
                                s5_c_re[j], s5_c_im[j], s5_d[j], s5_w_glu[j], not last)
        else:
            y_l, y_c = mlstm_mixer(u_l, u_c, ml_w_in[j], ml_b_gates[j], ml_norm[j], ml_w_out[j], not last)
        x = x + mod_l[2] * y_l
        if last:
            f_l = swiglu(modulate(rmsnorm(x, norm2[i]), mod_l[3], mod_l[4]), ffn_w_in[i], ffn_w_out[i])
            x = x + mod_l[5] * f_l
        else:
            ctx = ctx + mod_c[2] * y_c
            u = jnp.concatenate([modulate(rmsnorm(ctx, norm2[i]), mod_c[3], mod_c[4]),
                                 modulate(rmsnorm(x, norm2[i]), mod_l[3], mod_l[4])], axis=1)
            f = swiglu(u, ffn_w_in[i], ffn_w_out[i])
            ctx = ctx + mod_c[5] * f[:, :ctx_len]
            x = x + mod_l[5] * f[:, ctx_len:]
    return rmsnorm(x, norm_f)
```

```cpp
#include <hip/hip_runtime.h>
#include <cstdio>
namespace pg8 {
#define PG8_LAS __attribute__((address_space(3)))
typedef unsigned short bf16_t;
typedef short bf16x8 __attribute__((ext_vector_type(8)));
typedef float f32x4 __attribute__((ext_vector_type(4)));
typedef unsigned u32x4 __attribute__((ext_vector_type(4)));
constexpr int BM = 256, BK = 64, HALF = 128, HTB = HALF * BK * 2  , STAGE_BYTES = 8 * HTB, NXCD = 8, WGM = 4;

__host__ __device__ __forceinline__ int lds_byte(int r, int c) { const int st = (r >> 4) * 2 + (c >> 5), rr = r & 15, cc = c & 31, ob = rr * 64 + cc * 2; return st * 1024 + (ob ^ (((ob >> 9) & 1) << 5)); }
__host__ __device__ __forceinline__ void stage_rc(int b, int& R, int& C) { const int st = b / 1024, sb = b % 1024, swz = sb ^ (((sb >> 9) & 1) << 5); R = (st >> 1) * 16 + swz / 64; C = (st & 1) * 32 + (swz % 64) / 2; }
__host__ __device__ __forceinline__ int perm32(int rho) { const int n = rho >> 4, i = rho & 15; return 8 * (i >> 2) + 4 * n + (i & 3); }

struct Unit { int pm, pn, k0, nt, ks; };
struct Gemm { const bf16_t* A; const bf16_t* Bt; int M, N, K; };

struct StaticOrder {
    int nM, nN, nwg, G, c, ntile;
    __host__ __device__ void init(int M, int N, int G_, int c_, int K_) { nM = M / BM; nN = N / BM; nwg = nM * nN; G = G_; c = c_; ntile = K_ / BK; }
    __host__ __device__ bool next(int i, Unit& u) const {
        const long L = (long)i * G + c; if (L >= nwg) return false;
        int wgid = (int)L; { const int q = nwg / NXCD, r = nwg % NXCD, xcd = wgid % NXCD, off = wgid / NXCD; wgid = (xcd < r ? xcd * (q + 1) : r * (q + 1) + (xcd - r) * q) + off; }
        const int nig = WGM * nN, gid = wgid / nig, fm = gid * WGM, gsz = (nM - fm) < WGM ? (nM - fm) : WGM;
        u.pm = fm + ((wgid % nig) % gsz); u.pn = (wgid % nig) / gsz; u.k0 = 0; u.nt = ntile; u.ks = 0; return true;
    }
    __device__ __forceinline__ void a_ready(const Unit&) const {}
    __device__ __forceinline__ void done(const Unit&) const {}
};

typedef __bf16 bf16v2_t __attribute__((ext_vector_type(2))); typedef float f32v2_t __attribute__((ext_vector_type(2)));
__device__ __forceinline__ unsigned cvt_pk_bf16(float lo, float hi) { const f32v2_t v = {lo, hi}; return __builtin_bit_cast(unsigned, __builtin_convertvector(v, bf16v2_t)); }
template <class Epi, class Sched, bool ALIGN_EPI = false, bool SP2 = false>
__device__ __forceinline__ void gemm_phase(PG8_LAS unsigned char* lds, const Gemm g, const Sched& S, const Epi& E, int tid_in) {
    int tid_l = tid_in; asm volatile("" : "+v"(tid_l));
    const int tid = tid_l, wid = __builtin_amdgcn_readfirstlane(tid >> 6), lane = tid & 63, wr = wid >> 2, wc = wid & 3, fr = lane & 15, fq = lane >> 4;
    const int K = g.K;
    unsigned voffA[2], voffB[2];
#pragma unroll
    for (int i = 0; i < 2; ++i) { int R, C; stage_rc(tid * 16 + i * 8192, R, C); const int Rb = Epi::PERM ? ((R & ~31) + perm32(R & 31)) : R;
        voffA[i] = (unsigned)(R * K + C) * 2u; voffB[i] = (unsigned)(Rb * K + C) * 2u; }
    const size_t kstep = (size_t)(BK * 2);
    const size_t hstep = (size_t)HALF * K * 2;
    const size_t tstep = 2 * hstep;
    const unsigned ldsw = (unsigned)wid * 1024u;
    const int aoff = lds_byte(wr * 64 + fr, fq * 8), boff = lds_byte(wc * 32 + fr, fq * 8);
#define PG8_SA(b, h) (((b) * 2 + (h)) * HTB)
#define PG8_SB(b, h) ((4 + (b) * 2 + (h)) * HTB)
#define PG8_STAGE(bufoff, gbase, voff) do { _Pragma("unroll") for (int _i = 0; _i < 2; ++_i) \
        __builtin_amdgcn_global_load_lds((const unsigned*)((const char*)(gbase) + (voff)[_i]), (PG8_LAS unsigned*)(lds + (bufoff) + ldsw + _i * 8192), 16, 0, 0); } while (0)
#define PG8_LDA(dst, b, h) do { _Pragma("unroll") for (int m = 0; m < 4; ++m) _Pragma("unroll") for (int k = 0; k < 2; ++k) dst[m][k] = *(const PG8_LAS bf16x8*)(lds + PG8_SA(b, h) + aoff + m * 2048 + k * 1024); } while (0)
#define PG8_LDB(dst, b, h) do { _Pragma("unroll") for (int n = 0; n < 2; ++n) _Pragma("unroll") for (int k = 0; k < 2; ++k) dst[n][k] = *(const PG8_LAS bf16x8*)(lds + PG8_SB(b, h) + boff + n * 2048 + k * 1024); } while (0)
#define PG8_MMA(ai, bj, At, Bt) do { __builtin_amdgcn_s_setprio(1); _Pragma("unroll") for (int m = 0; m < 4; ++m) _Pragma("unroll") for (int n = 0; n < 2; ++n) _Pragma("unroll") for (int k = 0; k < 2; ++k) \
        acc[ai][bj][m][n] = __builtin_amdgcn_mfma_f32_16x16x32_bf16(Bt[n][k], At[m][k], acc[ai][bj][m][n], 0, 0, 0); __builtin_amdgcn_s_setprio(0); } while (0)
#define PG8_WAIT_V(n) asm volatile("s_waitcnt vmcnt(" #n ")" ::: "memory")
#define PG8_WAIT_L(n) asm volatile("s_waitcnt lgkmcnt(" #n ")" ::: "memory")
#define PG8_WAIT_V8R(relax) asm volatile("s_cmp_eq_u32 %0, 0\n\ts_cbranch_scc1 1f\n\ts_waitcnt vmcnt(%1)\n\ts_branch 2f\n1:\n\ts_waitcnt vmcnt(8)\n2:" :: "s"(relax), "i"(8 + Epi::NOPS) : "memory", "scc")
#define PG8_BAR __builtin_amdgcn_s_barrier()
#define PG8_SCHED __builtin_amdgcn_sched_barrier(0)
    Unit cur, nxt; int ui = 0;
    if (!S.next(0, cur)) return;
    f32x4 acc[2][2][4][2];
#pragma unroll
    for (int a = 0; a < 2; ++a)
#pragma unroll
        for (int b = 0; b < 2; ++b)
#pragma unroll
            for (int m = 0; m < 4; ++m)
#pragma unroll
                for (int n = 0; n < 2; ++n) acc[a][b][m][n] = (f32x4){0.f, 0.f, 0.f, 0.f};
    bf16x8 At[4][2], B0[2][2], B1[2][2];
    const char* cA = (const char*)g.A + (size_t)cur.pm * tstep + (size_t)cur.k0 * 2; const char* cB = (const char*)g.Bt + (size_t)cur.pn * tstep + (size_t)cur.k0 * 2;
    S.a_ready(cur);
    if constexpr (SP2) {
        PG8_STAGE(PG8_SB(0, 0), cB, voffB); PG8_STAGE(PG8_SB(0, 1), cB + hstep, voffB); PG8_STAGE(PG8_SA(0, 0), cA, voffA); PG8_STAGE(PG8_SA(0, 1), cA + hstep, voffA);
        if (wr == 1) PG8_BAR;
        PG8_WAIT_V(2); PG8_BAR;
        PG8_STAGE(PG8_SB(1, 0), cB + kstep, voffB); PG8_STAGE(PG8_SA(1, 0), cA + kstep, voffA); PG8_STAGE(PG8_SB(1, 1), cB + hstep + kstep, voffB);
        PG8_WAIT_V(6); PG8_BAR;
    } else {
        PG8_STAGE(PG8_SB(0, 0), cB, voffB); PG8_STAGE(PG8_SA(0, 0), cA, voffA); PG8_STAGE(PG8_SB(0, 1), cB + hstep, voffB); PG8_STAGE(PG8_SA(0, 1), cA + hstep, voffA);
        if (wr == 1) PG8_BAR;
        PG8_WAIT_V(4); PG8_BAR;
        PG8_STAGE(PG8_SB(1, 0), cB + kstep, voffB); PG8_STAGE(PG8_SA(1, 0), cA + kstep, voffA); PG8_STAGE(PG8_SB(1, 1), cB + hstep + kstep, voffB);
        PG8_WAIT_V(6); PG8_BAR;
    }
    for (;;) {
        const bool has_next = S.next(ui + 1, nxt);
        const char* nA = has_next ? (const char*)g.A + (size_t)nxt.pm * tstep + (size_t)nxt.k0 * 2 : cA; const char* nB = has_next ? (const char*)g.Bt + (size_t)nxt.pn * tstep + (size_t)nxt.k0 * 2 : cB;
        const int nt = cur.nt;
        for (int t = 0; t < nt; t += 2) {
            const bool last = (t == nt - 2);
            const char* a1 = cA + (size_t)(t + 1) * kstep;
            const char* a2 = last ? nA : cA + (size_t)(t + 2) * kstep; const char* b2 = last ? nB : cB + (size_t)(t + 2) * kstep;
            const char* a3 = a2 + kstep; const char* b3 = b2 + kstep;
            if (last && has_next) S.a_ready(nxt);
            if constexpr (SP2) {
            PG8_LDB(B0, 0, 0); PG8_LDB(B1, 0, 1); PG8_SCHED; PG8_LDA(At, 0, 0); PG8_STAGE(PG8_SA(1, 1), a1 + hstep, voffA);
            PG8_WAIT_V(8); PG8_WAIT_L(0); PG8_BAR; PG8_MMA(0, 0, At, B0); PG8_MMA(0, 1, At, B1); PG8_BAR; PG8_SCHED;
            PG8_LDA(At, 0, 1); PG8_STAGE(PG8_SB(0, 0), b2, voffB); PG8_STAGE(PG8_SB(0, 1), b2 + hstep, voffB); PG8_STAGE(PG8_SA(0, 0), a2, voffA);
            PG8_WAIT_V(8); PG8_WAIT_L(0); PG8_BAR; PG8_MMA(1, 0, At, B0); PG8_MMA(1, 1, At, B1); PG8_BAR; PG8_SCHED;
            PG8_LDB(B0, 1, 0); PG8_LDB(B1, 1, 1); PG8_SCHED; PG8_LDA(At, 1, 0); PG8_STAGE(PG8_SA(0, 1), a2 + hstep, voffA);
            PG8_WAIT_V(8); PG8_WAIT_L(0); PG8_BAR; PG8_MMA(0, 0, At, B0); PG8_MMA(0, 1, At, B1); PG8_BAR; PG8_SCHED;
            PG8_LDA(At, 1, 1); PG8_STAGE(PG8_SB(1, 0), b3, voffB); PG8_STAGE(PG8_SB(1, 1), b3 + hstep, voffB); PG8_STAGE(PG8_SA(1, 0), a3, voffA);
            PG8_WAIT_V(8); PG8_WAIT_L(0); PG8_BAR; PG8_MMA(1, 0, At, B0); PG8_MMA(1, 1, At, B1); PG8_BAR; PG8_SCHED;
            } else {
            PG8_LDB(B0, 0, 0); PG8_SCHED; PG8_LDA(At, 0, 0); PG8_STAGE(PG8_SA(1, 1), a1 + hstep, voffA);
            PG8_WAIT_L(8); PG8_BAR; PG8_WAIT_L(0); PG8_MMA(0, 0, At, B0); PG8_BAR; PG8_SCHED;
            PG8_LDB(B1, 0, 1); PG8_STAGE(PG8_SB(0, 0), b2, voffB);
            PG8_BAR; PG8_WAIT_L(0); PG8_MMA(0, 1, At, B1); PG8_BAR;
            PG8_LDA(At, 0, 1); PG8_STAGE(PG8_SA(0, 0), a2, voffA);
            PG8_BAR; PG8_WAIT_L(0); PG8_MMA(1, 0, At, B0); PG8_BAR; PG8_SCHED;
            PG8_STAGE(PG8_SB(0, 1), b2 + hstep, voffB);
            PG8_WAIT_V(6); PG8_BAR; PG8_MMA(1, 1, At, B1); PG8_BAR;
            PG8_LDB(B0, 1, 0); PG8_SCHED; PG8_LDA(At, 1, 0); PG8_STAGE(PG8_SA(0, 1), a2 + hstep, voffA);
            PG8_WAIT_L(8); PG8_BAR; PG8_WAIT_L(0); PG8_MMA(0, 0, At, B0); PG8_BAR; PG8_SCHED;
            PG8_LDB(B1, 1, 1); PG8_STAGE(PG8_SB(1, 0), b3, voffB);
            PG8_BAR; PG8_WAIT_L(0); PG8_MMA(0, 1, At, B1); PG8_BAR;
            PG8_LDA(At, 1, 1); PG8_STAGE(PG8_SA(1, 0), a3, voffA);
            PG8_BAR; PG8_WAIT_L(0); PG8_MMA(1, 0, At, B0); PG8_BAR; PG8_SCHED;
            PG8_STAGE(PG8_SB(1, 1), b3 + hstep, voffB);
            PG8_WAIT_V(6); PG8_BAR; PG8_MMA(1, 1, At, B1); PG8_BAR;
            }
        }
        if constexpr (ALIGN_EPI) { if (wr == 0) PG8_BAR; }
        if constexpr (!Epi::AFTER_DRAIN) { E(acc, cur, wr, wc, fr, fq);
#if defined(PROBE_EPI2)
            if constexpr (Epi::PERM) { asm volatile("" ::: "memory"); E(acc, cur, wr, wc, fr, fq); }
#endif
            S.done(cur); }
        if (!has_next) break;
#pragma unroll
        for (int a = 0; a < 2; ++a)
#pragma unroll
            for (int b = 0; b < 2; ++b)
#pragma unroll
                for (int m = 0; m < 4; ++m)
#pragma unroll
                    for (int n = 0; n < 2; ++n) acc[a][b][m][n] = (f32x4){0.f, 0.f, 0.f, 0.f};
        cur = nxt; cA = nA; cB = nB; ++ui;
        if constexpr (ALIGN_EPI) { if (wr == 1) PG8_BAR; }
    }
    PG8_WAIT_V(0);
    if constexpr (!ALIGN_EPI) { if (wr == 0) PG8_BAR; }
    PG8_BAR;
    if constexpr (Epi::AFTER_DRAIN) { E.fused(acc, cur, wr, wc, fr, fq, lds, wid, lane); S.done(cur); }
#undef PG8_SA
#undef PG8_SB
#undef PG8_STAGE
#undef PG8_LDA
#undef PG8_LDB
#undef PG8_MMA
#undef PG8_WAIT_V
#undef PG8_WAIT_L
#undef PG8_WAIT_V8R
#undef PG8_BAR
#undef PG8_SCHED
}
}

#ifndef MK_ONE_LAUNCH
#define MK_ONE_LAUNCH 1
#endif
constexpr int D = 2048, NBATCH = 4, SEQ = 4096, CTXL = 256, DEPTH = 4;
constexpr int NRC = NBATCH * CTXL, NRL = NBATCH * SEQ, NR = NRC + NRL;
constexpr int FF = 5632, MLIN = 6176, MLINP = 6400;
constexpr int NHEAD = 8, DV = 256, DQK = 128;
constexpr float EPSN = 1e-6f;
constexpr int NWAVES = 8;

constexpr size_t MiB = 1u << 20;
constexpr size_t WS_CTL = 0, CTL_ZERO_BYTES = 1 * MiB;
constexpr size_t WS_MOD = 1 * MiB;
constexpr size_t WS_WFFI = 2 * MiB,   SZ_WFFI = (size_t)2 * FF * D * 2;
constexpr size_t WS_WFFO = 178 * MiB, SZ_WFFO = (size_t)D * FF * 2;
constexpr size_t WS_WGLU = 266 * MiB, SZ_WGLU = (size_t)2 * D * D * 2;
constexpr size_t WS_WMLI = 298 * MiB, SZ_WMLI = (size_t)MLINP * D * 2;
constexpr size_t WS_WMLO = 348 * MiB, SZ_WMLO = (size_t)D * D * 2;
constexpr size_t WS_X = 364 * MiB;
constexpr size_t WS_U = 500 * MiB;
constexpr size_t WS_G = 568 * MiB;
constexpr size_t WS_HID = 636 * MiB;
constexpr size_t WS_TA = 823 * MiB, SZ_F32ROWS = (size_t)NR * D * 4;
constexpr size_t WS_Q = 1095 * MiB, WS_K = 1129 * MiB, WS_V = 1163 * MiB, WS_O = 1231 * MiB, WS_GATES = 1299 * MiB;
constexpr size_t WS_END = 1302 * MiB;
static_assert(WS_WFFI + 4 * SZ_WFFI <= WS_WFFO && WS_WFFO + 4 * SZ_WFFO <= WS_WGLU && WS_WGLU + 2 * SZ_WGLU <= WS_WMLI && WS_WMLI + 2 * SZ_WMLI <= WS_WMLO && WS_WMLO + 2 * SZ_WMLO <= WS_X, "ws map 1");
static_assert(WS_X + SZ_F32ROWS <= WS_U && WS_U + (size_t)NR * D * 2 <= WS_G && WS_G + (size_t)NR * D * 2 <= WS_HID && WS_HID + (size_t)NR * FF * 2 <= WS_TA && WS_TA + 2 * SZ_F32ROWS <= WS_Q, "ws map 2");
static_assert(WS_Q + (size_t)NR * 1024 * 2 <= WS_K && WS_K + (size_t)NR * 1024 * 2 <= WS_V && WS_V + (size_t)NR * D * 2 <= WS_O && WS_O + (size_t)NR * D * 2 <= WS_GATES && WS_GATES + (size_t)NR * 32 * 4 <= WS_END, "ws map 3");
constexpr int CW_BAR = 4096;

constexpr int RING_BYTES = 131072, LDSCTL_OFF = RING_BYTES, MISC_OFF = LDSCTL_OFF + 320, LDS_BYTES = 147456;

#define GAS __attribute__((address_space(1)))
#define LAS __attribute__((address_space(3)))
typedef unsigned short bf16;
typedef unsigned v4u __attribute__((ext_vector_type(4)));
typedef unsigned v2u __attribute__((ext_vector_type(2)));
typedef float f32x4 __attribute__((ext_vector_type(4)));
typedef short bf16x8 __attribute__((ext_vector_type(8)));

__device__ __forceinline__ unsigned f2bf(float f) { unsigned u = __builtin_bit_cast(unsigned, f); return (u + 0x7fffu + ((u >> 16) & 1u)) >> 16; }
__device__ __forceinline__ unsigned pk2(float lo, float hi) { return pg8::cvt_pk_bf16(lo, hi); }
__device__ __forceinline__ float bflo(unsigned w) { return __builtin_bit_cast(float, w << 16); }
__device__ __forceinline__ float bfhi(unsigned w) { return __builtin_bit_cast(float, w & 0xffff0000u); }
__device__ __forceinline__ float bf2f(bf16 b) { return __builtin_bit_cast(float, ((unsigned)b) << 16); }
__device__ __forceinline__ float fsigmoid(float x) { return __builtin_amdgcn_rcpf(1.0f + __builtin_amdgcn_exp2f(-1.4426950408889634f * x)); }
__device__ __forceinline__ float wave_sum(float v) {
#pragma unroll
    for (int o = 1; o < 64; o <<= 1) v += __shfl_xor(v, o);
    return v;
}

#define XB_TMO      128
#define XB_XCNT(j)  (256  + 64 * (j))
#define XB_XSUB(j)  (1280 + 64 * (j))
#define XB_XGEN(j)  (2304 + 64 * (j))
#define XB_TOP      3328
#define XB_TOPGEN   3392
#define XCD_BAR_WORDS 3456
#define XB_SPIN_CAP (1u << 18)
__device__ __forceinline__ unsigned xb_ld(unsigned* p)              { return __hip_atomic_load(p, __ATOMIC_RELAXED, __HIP_MEMORY_SCOPE_AGENT); }
__device__ __forceinline__ unsigned xb_add(unsigned* p, unsigned v) { return __hip_atomic_fetch_add(p, v, __ATOMIC_RELAXED, __HIP_MEMORY_SCOPE_AGENT); }
__device__ __forceinline__ unsigned xb_xcc_id() { return (unsigned)__builtin_amdgcn_s_getreg((3 << 11) | 20) & 0xFu; }
#define XB_SPIN(cond, bar) do { unsigned _sp = 0; while (cond) { __builtin_amdgcn_s_sleep(1); \
    if ((++_sp & 255u) == 0u) { if (xb_ld(&(bar)[XB_TMO])) break; if (_sp > XB_SPIN_CAP) { atomicAdd(&(bar)[XB_TMO], 1u); break; } } } } while (0)
__device__ __forceinline__ int mk_lane() { unsigned m = ~0u; asm volatile("" : "+s"(m)); return (int)__builtin_amdgcn_mbcnt_hi(m, __builtin_amdgcn_mbcnt_lo(m, 0u)); }
struct XcdBarrier { unsigned* bar; unsigned x; volatile LAS unsigned* st; };
__device__ __forceinline__ XcdBarrier xcd_barrier_post(unsigned* bar, volatile LAS unsigned* st, int wave) {
    XcdBarrier b; b.bar = bar; b.x = xb_xcc_id(); b.st = st;
    if (wave == 0 && mk_lane() == 0) (void)xb_add(&bar[XB_XCNT(b.x)], 1u);
    return b;
}
__device__ __forceinline__ void xcd_barrier_complete(unsigned* bar, unsigned x, unsigned& nloc, unsigned& nx) {
    const unsigned G = gridDim.x * gridDim.y * gridDim.z;
    unsigned sum, cnt, mine, sp = 0u;
    for (;;) {
        sum = 0u; cnt = 0u; mine = 0u;
#pragma unroll
        for (unsigned j = 0; j < 16; ++j) { const unsigned c = xb_ld(&bar[XB_XCNT(j)]); sum += c; cnt += (c > 0u) ? 1u : 0u; mine = (j == x) ? c : mine; }
        if (sum == G) break;
        __builtin_amdgcn_s_sleep(1);
        if ((++sp & 255u) == 0u) { if (xb_ld(&bar[XB_TMO])) break; if (sp > XB_SPIN_CAP) { atomicAdd(&bar[XB_TMO], 1u); break; } }
    }
    nloc = mine > 0u ? mine : 1u; nx = cnt > 0u ? cnt : 1u;
}
__device__ __forceinline__ void xcd_barrier(const XcdBarrier& b, int wave) {
    asm volatile("s_waitcnt vmcnt(0)" ::: "memory");
    __syncthreads();
    if (wave == 0 && mk_lane() == 0) {
        unsigned* bar = b.bar;
        __builtin_amdgcn_s_waitcnt(0);
        unsigned nloc = b.st[0], nx = b.st[1];
        if (nloc == 0u) { xcd_barrier_complete(bar, b.x, nloc, nx); b.st[0] = nloc; b.st[1] = nx; }
        const unsigned old = xb_add(&bar[XB_XSUB(b.x)], 1u);
        const unsigned gen = old / nloc;
        if (old + 1u == (gen + 1u) * nloc) {
            __builtin_amdgcn_fence(__ATOMIC_RELEASE, "agent");
            asm volatile("s_waitcnt vmcnt(0)" ::: "memory");
            const unsigned og = xb_add(&bar[XB_TOP], 1u);
            const unsigned tg = og / nx;
            if (og + 1u == (tg + 1u) * nx) xb_add(&bar[XB_TOPGEN], 1u);
            else XB_SPIN(xb_ld(&bar[XB_TOPGEN]) == tg, bar);
            __builtin_amdgcn_fence(__ATOMIC_ACQUIRE, "agent");
            xb_add(&bar[XB_XGEN(b.x)], 1u);
            asm volatile("s_waitcnt vmcnt(0)" ::: "memory");
        } else {
            XB_SPIN(xb_ld(&bar[XB_XGEN(b.x)]) == gen, bar);
            __builtin_amdgcn_fence(__ATOMIC_ACQUIRE, "agent");
            asm volatile("s_waitcnt vmcnt(0)" ::: "memory");
        }
    }
    __syncthreads();
}

__device__ __forceinline__ int row_r(int pm) { return pm < 4 ? 4 : ((pm - 4) >> 4); }

struct EpiGlu {
    static constexpr bool PERM = true, AFTER_DRAIN = false;
    static constexpr int NOPS = 18;
    const float* b32ctx; const float* b32lat; bf16* X; const float* mod; int pm0; int src32;
    __device__ __forceinline__ void operator()(const pg8::f32x4 (&acc)[2][2][4][2], const pg8::Unit& u, int wr, int wc, int fr, int fq) const {
        const int pmg = u.pm + pm0; const int r = row_r(pmg); const int j0 = u.pn * 128 + wc * 32 + 8 * fq;
        const float* gp = mod + (size_t)(r * 6 + 2) * D + j0;
        const f32x4 g0 = *(const f32x4*)gp, g1 = *(const f32x4*)(gp + 4);
        if (src32) {
            f32x4 bs[2][4][2];
#pragma unroll
            for (int ai = 0; ai < 2; ++ai)
#pragma unroll
                for (int m = 0; m < 4; ++m) {
                    const int R = pmg * 256 + ai * 128 + wr * 64 + m * 16 + fr;
                    const float* bp = (R < NRC ? b32ctx + (size_t)R * D : b32lat + (size_t)(R - NRC) * D) + j0;
#pragma unroll
                    for (int n = 0; n < 2; ++n) bs[ai][m][n] = __builtin_nontemporal_load((const f32x4*)(bp + 4 * n)); }
            asm volatile("" ::: "memory");
#pragma unroll
            for (int ai = 0; ai < 2; ++ai)
#pragma unroll
                for (int m = 0; m < 4; ++m) {
                    const int R = pmg * 256 + ai * 128 + wr * 64 + m * 16 + fr;
                    float o[8];
#pragma unroll
                    for (int n = 0; n < 2; ++n) {
                        const f32x4 a = acc[ai][0][m][n], b = acc[ai][1][m][n]; const f32x4 gv = n ? g1 : g0;
#pragma unroll
                        for (int e = 0; e < 4; ++e) o[4 * n + e] = bs[ai][m][n][e] + gv[e] * (a[e] * fsigmoid(b[e])); }
                    v4u w; w.x = pg8::cvt_pk_bf16(o[0], o[1]); w.y = pg8::cvt_pk_bf16(o[2], o[3]); w.z = pg8::cvt_pk_bf16(o[4], o[5]); w.w = pg8::cvt_pk_bf16(o[6], o[7]);
                    *(v4u*)(X + (size_t)R * D + j0) = w; }
        } else {
            v4u bs[2][4];
#pragma unroll
            for (int ai = 0; ai < 2; ++ai)
#pragma unroll
                for (int m = 0; m < 4; ++m) { const int R = pmg * 256 + ai * 128 + wr * 64 + m * 16 + fr; bs[ai][m] = *(const v4u*)(X + (size_t)R * D + j0); }
            asm volatile("" ::: "memory");
#pragma unroll
            for (int ai = 0; ai < 2; ++ai)
#pragma unroll
                for (int m = 0; m < 4; ++m) {
                    const int R = pmg * 256 + ai * 128 + wr * 64 + m * 16 + fr;
                    const v4u bw = bs[ai][m]; const float bv[8] = {bflo(bw.x), bfhi(bw.x), bflo(bw.y), bfhi(bw.y), bflo(bw.z), bfhi(bw.z), bflo(bw.w), bfhi(bw.w)};
                    float o[8];
#pragma unroll
                    for (int n = 0; n < 2; ++n) {
                        const f32x4 a = acc[ai][0][m][n], b = acc[ai][1][m][n]; const f32x4 gv = n ? g1 : g0;
#pragma unroll
                        for (int e = 0; e < 4; ++e) o[4 * n + e] = bv[4 * n + e] + gv[e] * (a[e] * fsigmoid(b[e])); }
                    v4u w; w.x = pg8::cvt_pk_bf16(o[0], o[1]); w.y = pg8::cvt_pk_bf16(o[2], o[3]); w.z = pg8::cvt_pk_bf16(o[4], o[5]); w.w = pg8::cvt_pk_bf16(o[6], o[7]);
                    *(v4u*)(X + (size_t)R * D + j0) = w; }
        }
    }
};
struct EpiFfi {
    static constexpr bool PERM = true, AFTER_DRAIN = false;
    bf16* H; int pm0;
    static constexpr int NOPS = 8;
    __device__ __forceinline__ void operator()(const pg8::f32x4 (&acc)[2][2][4][2], const pg8::Unit& u, int wr, int wc, int fr, int fq) const {
        const int j0 = u.pn * 128 + wc * 32 + 8 * fq;
#pragma unroll
        for (int ai = 0; ai < 2; ++ai)
#pragma unroll
            for (int m = 0; m < 4; ++m) {
                const int R = (u.pm + pm0) * 256 + ai * 128 + wr * 64 + m * 16 + fr;
                float h[8];
#pragma unroll
                for (int n = 0; n < 2; ++n)
#pragma unroll
                    for (int e = 0; e < 4; ++e) { const float g = acc[ai][0][m][n][e], up = acc[ai][1][m][n][e]; h[4 * n + e] = g * fsigmoid(g) * up; }
                v4u w; w.x = pg8::cvt_pk_bf16(h[0], h[1]); w.y = pg8::cvt_pk_bf16(h[2], h[3]); w.z = pg8::cvt_pk_bf16(h[4], h[5]); w.w = pg8::cvt_pk_bf16(h[6], h[7]);
                *(v4u*)(H + (size_t)R * FF + j0) = w; }
    }
};
template <bool MLPERM> struct EpiRes {
    static constexpr bool PERM = true, AFTER_DRAIN = false;
    bf16* X; const float* mod; int gidx; int pm0;
    static constexpr int NOPS = 16;
    __device__ __forceinline__ void operator()(const pg8::f32x4 (&acc)[2][2][4][2], const pg8::Unit& u, int wr, int wc, int fr, int fq) const {
        const int pmg = u.pm + pm0; const int r = row_r(pmg); const int c0 = u.pn * 256 + wc * 32 + 8 * fq;
        const float* gp = mod + (size_t)(r * 6 + gidx) * D + c0;
        f32x4 gv[2][2];
#pragma unroll
        for (int bj = 0; bj < 2; ++bj)
#pragma unroll
            for (int n = 0; n < 2; ++n) gv[bj][n] = *(const f32x4*)(gp + bj * 128 + n * 4);
        v4u bs[2][4][2];
#pragma unroll
        for (int ai = 0; ai < 2; ++ai)
#pragma unroll
            for (int m = 0; m < 4; ++m) {
                int R = pmg * 256 + ai * 128 + wr * 64 + m * 16 + fr;
                if (MLPERM && R >= NRC) { const int q = R - NRC, p = q & 4095; R = NRC + (q & ~4095) + ((p & 63) << 6) + (p >> 6); }
                const bf16* xp = X + (size_t)R * D + c0;
#pragma unroll
                for (int bj = 0; bj < 2; ++bj) bs[ai][m][bj] = *(const v4u*)(xp + bj * 128); }
        asm volatile("" ::: "memory");
#pragma unroll
        for (int ai = 0; ai < 2; ++ai)
#pragma unroll
            for (int m = 0; m < 4; ++m) {
                int R = pmg * 256 + ai * 128 + wr * 64 + m * 16 + fr;
                if (MLPERM && R >= NRC) { const int q = R - NRC, p = q & 4095; R = NRC + (q & ~4095) + ((p & 63) << 6) + (p >> 6); }
                bf16* xp = X + (size_t)R * D + c0;
#pragma unroll
                for (int bj = 0; bj < 2; ++bj) {
                    const v4u bw = bs[ai][m][bj]; const f32x4 a0 = acc[ai][bj][m][0], a1 = acc[ai][bj][m][1], ga = gv[bj][0], gb = gv[bj][1];
                    v4u w; w.x = pg8::cvt_pk_bf16(bflo(bw.x) + ga[0] * a0[0], bfhi(bw.x) + ga[1] * a0[1]); w.y = pg8::cvt_pk_bf16(bflo(bw.y) + ga[2] * a0[2], bfhi(bw.y) + ga[3] * a0[3]);
                    w.z = pg8::cvt_pk_bf16(bflo(bw.z) + gb[0] * a1[0], bfhi(bw.z) + gb[1] * a1[1]); w.w = pg8::cvt_pk_bf16(bflo(bw.w) + gb[2] * a1[2], bfhi(bw.w) + gb[3] * a1[3]);
                    *(v4u*)(xp + bj * 128) = w; } }
    }
};
struct EpiSlab {
    static constexpr bool PERM = true, AFTER_DRAIN = false;
    bf16* slab; const float* mod; int gidx;
    static constexpr int NOPS = 12;
    __device__ __forceinline__ void operator()(const pg8::f32x4 (&acc)[2][2][4][2], const pg8::Unit& u, int wr, int wc, int fr, int fq) const {
        const int c0 = u.pn * 256 + wc * 32 + 8 * fq;
        const float* gp = mod + (size_t)(4 * 6 + gidx) * D + c0;
        f32x4 gv[2][2];
#pragma unroll
        for (int bj = 0; bj < 2; ++bj)
#pragma unroll
            for (int n = 0; n < 2; ++n) gv[bj][n] = *(const f32x4*)(gp + bj * 128 + n * 4);
        bf16* sp = slab + (size_t)u.ks * NRC * D;
#pragma unroll
        for (int ai = 0; ai < 2; ++ai)
#pragma unroll
            for (int m = 0; m < 4; ++m) {
                const int R = u.pm * 256 + ai * 128 + wr * 64 + m * 16 + fr;
                bf16* xp = sp + (size_t)R * D + c0;
#pragma unroll
                for (int bj = 0; bj < 2; ++bj) { const f32x4 p0 = gv[bj][0] * acc[ai][bj][m][0], p1 = gv[bj][1] * acc[ai][bj][m][1];
                    v4u w; w.x = pg8::cvt_pk_bf16(p0[0], p0[1]); w.y = pg8::cvt_pk_bf16(p0[2], p0[3]); w.z = pg8::cvt_pk_bf16(p1[0], p1[1]); w.w = pg8::cvt_pk_bf16(p1[2], p1[3]);
                    *(v4u*)(xp + bj * 128) = w; } }
    }
};
struct CtxSplitOrder {
    int G, c, npn, t_hi, n_hi;
    __device__ __forceinline__ bool next(int i, pg8::Unit& u) const {
        const int L = i * G + c; if (L >= 32 * npn) return false;
        const int ks = L & 7, rest = L >> 3; u.pn = rest % npn; u.pm = rest / npn; u.ks = ks;
        u.nt = ks < n_hi ? t_hi : t_hi - 2; u.k0 = 64 * (ks < n_hi ? ks * t_hi : n_hi * t_hi + (ks - n_hi) * (t_hi - 2)); return true;
    }
    __device__ __forceinline__ void a_ready(const pg8::Unit&) const {}
    __device__ __forceinline__ void done(const pg8::Unit&) const {}
};
struct ResCtxOrder {
    int G, c, t_full, t_hi, n_hi; bool with_ctx;
    __device__ __forceinline__ void init(int G_, int c_, int K, bool wc, int t_hi_, int n_hi_) { G = G_; c = c_; t_full = K / 64; t_hi = t_hi_; n_hi = n_hi_; with_ctx = wc; }
    __device__ __forceinline__ bool next(int i, pg8::Unit& u) const {
        constexpr int NLAT = (NRL / 256) * (D / 256);
        const int L = i * G + c;
        int pm, pn, k0, nt, ks; bool ok = true;
        if (L < NLAT) {
            int wgid = L; { const int q = NLAT / pg8::NXCD, xcd = wgid % pg8::NXCD, off = wgid / pg8::NXCD; wgid = xcd * q + off; }
            const int nig = pg8::WGM * (D / 256), gid = wgid / nig, fm = gid * pg8::WGM;
            pm = 4 + fm + ((wgid % nig) % pg8::WGM); pn = (wgid % nig) / pg8::WGM; k0 = 0; nt = t_full; ks = -1;
        } else {
            const int Lc = L - ((NLAT + G - 1) / G) * G;
            ok = with_ctx && Lc >= 0 && Lc < 32 * 8;
            ks = Lc & 7; const int rest = Lc >> 3; pn = rest & 7; pm = (rest >> 3) & 3;
            nt = ks < n_hi ? t_hi : t_hi - 2; k0 = 64 * (ks < n_hi ? ks * t_hi : n_hi * t_hi + (ks - n_hi) * (t_hi - 2));
        }
        u.pm = pm; u.pn = pn; u.k0 = k0; u.nt = nt; u.ks = ks; return ok;
    }
    __device__ __forceinline__ void a_ready(const pg8::Unit&) const {}
    __device__ __forceinline__ void done(const pg8::Unit&) const {}
};
struct EpiResSlab {
    static constexpr bool PERM = true, AFTER_DRAIN = false;
    static constexpr int NOPS = 12;
    bf16* X; bf16* slab; const float* mod; int gidx;
    __device__ __forceinline__ void operator()(const pg8::f32x4 (&acc)[2][2][4][2], const pg8::Unit& u, int wr, int wc, int fr, int fq) const {
        const bool lat = u.ks < 0;
        const int r = row_r(u.pm); const int c0 = u.pn * 256 + wc * 32 + 8 * fq;
        const float* gp = mod + (size_t)(r * 6 + gidx) * D + c0;
        f32x4 gv[2][2];
#pragma unroll
        for (int bj = 0; bj < 2; ++bj)
#pragma unroll
            for (int n = 0; n < 2; ++n) gv[bj][n] = *(const f32x4*)(gp + bj * 128 + n * 4);
        bf16* dst = (lat ? X : slab + (size_t)u.ks * NRC * D) + (size_t)(u.pm * 256 + wr * 64 + fr) * D + c0;
        v4u bs[2][4][2];
#pragma unroll
        for (int ai = 0; ai < 2; ++ai)
#pragma unroll
            for (int m = 0; m < 4; ++m)
#pragma unroll
                for (int bj = 0; bj < 2; ++bj) bs[ai][m][bj] = (v4u){0u, 0u, 0u, 0u};
        if (lat) {
#pragma unroll
            for (int ai = 0; ai < 2; ++ai)
#pragma unroll
                for (int m = 0; m < 4; ++m)
#pragma unroll
                    for (int bj = 0; bj < 2; ++bj) bs[ai][m][bj] = *(const v4u*)(dst + (size_t)(ai * 128 + m * 16) * D + bj * 128); }
        asm volatile("" ::: "memory");
#pragma unroll
        for (int ai = 0; ai < 2; ++ai)
#pragma unroll
            for (int m = 0; m < 4; ++m)
#pragma unroll
                for (int bj = 0; bj < 2; ++bj) {
                    const v4u bw = bs[ai][m][bj]; const f32x4 a0 = acc[ai][bj][m][0], a1 = acc[ai][bj][m][1], ga = gv[bj][0], gb = gv[bj][1];
                    v4u w; w.x = pg8::cvt_pk_bf16(bflo(bw.x) + ga[0] * a0[0], bfhi(bw.x) + ga[1] * a0[1]); w.y = pg8::cvt_pk_bf16(bflo(bw.y) + ga[2] * a0[2], bfhi(bw.y) + ga[3] * a0[3]);
                    w.z = pg8::cvt_pk_bf16(bflo(bw.z) + gb[0] * a1[0], bfhi(bw.z) + gb[1] * a1[1]); w.w = pg8::cvt_pk_bf16(bflo(bw.w) + gb[2] * a1[2], bfhi(bw.w) + gb[3] * a1[3]);
                    *(v4u*)(dst + (size_t)(ai * 128 + m * 16) * D + bj * 128) = w; }
    }
};
struct EpiMli {
    static constexpr bool PERM = true, AFTER_DRAIN = false;
    bf16 *Q, *K, *V, *O; float* GATES; const float* bg;
    static constexpr int NOPS = 0;
    __device__ __forceinline__ void operator()(const pg8::f32x4 (&acc)[2][2][4][2], const pg8::Unit& u, int wr, int wc, int fr, int fq) const {
        const int pn = u.pn;
        if (pn < 24) {
            bf16* base; int ldc, colt; float sc = 1.f;
            if (pn < 4) { base = Q; ldc = 1024; colt = pn * 256; sc = 0.08838834764831845f; } else if (pn < 8) { base = K; ldc = 1024; colt = (pn - 4) * 256; }
            else if (pn < 16) { base = V; ldc = D; colt = (pn - 8) * 256; } else { base = O; ldc = D; colt = (pn - 16) * 256; }
            const int col0 = colt + wc * 32 + 8 * fq;
#pragma unroll
            for (int ai = 0; ai < 2; ++ai)
#pragma unroll
                for (int m = 0; m < 4; ++m) {
                    const int R = u.pm * 256 + ai * 128 + wr * 64 + m * 16 + fr; bf16* rowp = base + (size_t)R * ldc + col0;
#pragma unroll
                    for (int bj = 0; bj < 2; ++bj) { const f32x4 v0 = acc[ai][bj][m][0] * sc, v1 = acc[ai][bj][m][1] * sc; v4u w;
                        w.x = pg8::cvt_pk_bf16(v0[0], v0[1]); w.y = pg8::cvt_pk_bf16(v0[2], v0[3]); w.z = pg8::cvt_pk_bf16(v1[0], v1[1]); w.w = pg8::cvt_pk_bf16(v1[2], v1[3]);
                        if (pn >= 16) __builtin_nontemporal_store(w, (v4u*)(rowp + bj * 128)); else *(v4u*)(rowp + bj * 128) = w; } }
        } else if (wc == 0) {
#pragma unroll
            for (int ai = 0; ai < 2; ++ai)
#pragma unroll
                for (int m = 0; m < 4; ++m) {
                    const int R = u.pm * 256 + ai * 128 + wr * 64 + m * 16 + fr;
#pragma unroll
                    for (int n = 0; n < 2; ++n) { const int gc = 8 * fq + 4 * n; const f32x4 bv = *(const f32x4*)(bg + gc); f32x4 o;
#pragma unroll
                        for (int e = 0; e < 4; ++e) { const float z = (acc[ai][0][m][n][e] + bv[e]) * (1.0f / 15.0f); float gcap = 15.0f * tanhf(z);
                            if (fq & 1) gcap = fminf(gcap, 0.f) - log1pf(expf(-fabsf(gcap)));
                            o[e] = gcap; }
                        *(f32x4*)(GATES + (size_t)R * 32 + gc) = o; } }
        }
    }
};

__device__ __forceinline__ void transpose_item(const float* W, int K, int N, bf16* WT, int kb, int n0, int drow0, LAS float* scr, int lane) {
    const int k0 = 64 * kb;
#pragma unroll 8
    for (int i = 0; i < 32; ++i) { const int kk = 2 * i + (lane >> 5); scr[kk * 33 + (lane & 31)] = __builtin_nontemporal_load(W + (size_t)(k0 + kk) * N + n0 + (lane & 31)); }
    asm volatile("s_waitcnt lgkmcnt(0)" ::: "memory");
    const int c = lane & 7;
#pragma unroll
    for (int j = 0; j < 4; ++j) { const int n = (lane >> 3) + 8 * j; const LAS float* s = scr + (8 * c) * 33 + n;
        v4u o; o.x = pk2(s[0 * 33], s[1 * 33]); o.y = pk2(s[2 * 33], s[3 * 33]); o.z = pk2(s[4 * 33], s[5 * 33]); o.w = pk2(s[6 * 33], s[7 * 33]);
        __builtin_nontemporal_store(o, (v4u*)(WT + (size_t)(drow0 + n) * K + k0 + 8 * c)); }
    asm volatile("s_waitcnt lgkmcnt(0)" ::: "memory");
}
__device__ __forceinline__ int pair_row(int n0, int F) { const int j0 = n0 < F ? n0 : n0 - F; return 256 * (j0 >> 7) + (j0 & 127) + (n0 < F ? 0 : 128); }

constexpr int I_FFI = 32 * 352, I_FFO = 88 * 64, I_GLU = 32 * 128, I_MLI = 32 * 193, I_MLO = 32 * 64;
constexpr int TRG_S5 = I_GLU + I_FFI + I_FFO, TRG_ML = I_MLI + I_MLO + I_FFI + I_FFO;
constexpr int TR_L1 = TRG_S5, TR_L2 = TR_L1 + TRG_ML, TR_L3 = TR_L2 + TRG_S5, TR_END = TR_L3 + TRG_ML;
struct TrItem { const float* W; bf16* WT; int K, N, kb, n0, drow0; };
__device__ __forceinline__ int pair_row_(int n0, int F) { const int j0 = n0 < F ? n0 : n0 - F; return 256 * (j0 >> 7) + (j0 & 127) + (n0 < F ? 0 : 128); }
__device__ __forceinline__ TrItem tr_decode(const float* w_ffi, const float* w_ffo, const float* w_glu, const float* w_mli, const float* w_mlo, unsigned char* ws, int it) {
    TrItem t; int layer, r;
    if (it < TR_L1) { layer = 0; r = it; } else if (it < TR_L2) { layer = 1; r = it - TR_L1; } else if (it < TR_L3) { layer = 2; r = it - TR_L2; } else { layer = 3; r = it - TR_L3; }
    const int j = layer >> 1;
    if ((layer & 1) == 0) {
        if (r < I_GLU) { t.W = w_glu + (size_t)j * D * 2 * D; t.WT = (bf16*)(ws + WS_WGLU + j * SZ_WGLU); t.K = D; t.N = 2 * D; t.kb = r / 128; t.n0 = 32 * (r % 128); t.drow0 = pair_row_(t.n0, D); return t; }
        r -= I_GLU;
    } else {
        if (r < I_MLI) { t.W = w_mli + (size_t)j * D * MLIN; t.WT = (bf16*)(ws + WS_WMLI + j * SZ_WMLI); t.K = D; t.N = MLIN; t.kb = r / 193; t.n0 = 32 * (r % 193); t.drow0 = t.n0; return t; }
        r -= I_MLI;
        if (r < I_MLO) { t.W = w_mlo + (size_t)j * D * D; t.WT = (bf16*)(ws + WS_WMLO + j * SZ_WMLO); t.K = D; t.N = D; t.kb = r / 64; t.n0 = 32 * (r % 64); t.drow0 = t.n0; return t; }
        r -= I_MLO;
    }
    if (r < I_FFI) { t.W = w_ffi + (size_t)layer * D * 2 * FF; t.WT = (bf16*)(ws + WS_WFFI + layer * SZ_WFFI); t.K = D; t.N = 2 * FF; t.kb = r / 352; t.n0 = 32 * (r % 352); t.drow0 = pair_row_(t.n0, FF); return t; }
    r -= I_FFI;
    t.W = w_ffo + (size_t)layer * FF * D; t.WT = (bf16*)(ws + WS_WFFO + layer * SZ_WFFO); t.K = FF; t.N = D; t.kb = r / 64; t.n0 = 32 * (r % 64); t.drow0 = t.n0; return t;
}
#ifndef TQ_G
#define TQ_G 13
#endif
#ifndef TQ_F
#define TQ_F 11
#endif
#ifndef TQ_M
#define TQ_M 11
#endif
constexpr int imin(int a, int b) { return a < b ? a : b; }
constexpr int imax(int a, int b) { return a > b ? a : b; }
constexpr int CAP_G = 192 * 8 * TQ_G, CAP_F = 80 * 8 * TQ_F, CAP_M = 92 * 8 * TQ_M;
constexpr int TAIL_GLU0_LO = TR_L1,        TAIL_GLU0_HI = imin(TAIL_GLU0_LO + CAP_G, TR_END);
constexpr int TAIL_FFI0_LO = TAIL_GLU0_HI, TAIL_FFI0_HI = imin(TAIL_FFI0_LO + CAP_F, TR_END);
constexpr int E1_LO = imin(TAIL_FFI0_HI, TR_L2), E1_HI = TR_L2;
constexpr int TAIL_MLI1_LO = imax(TAIL_FFI0_HI, TR_L2), TAIL_MLI1_HI = imin(TAIL_MLI1_LO + CAP_M, TR_END);
constexpr int TAIL_FFI1_LO = TAIL_MLI1_HI, TAIL_FFI1_HI = imin(TAIL_FFI1_LO + CAP_F, TR_END);
constexpr int E2_LO = imin(TAIL_FFI1_HI, TR_L3), E2_HI = TR_L3;
constexpr int TAIL_GLU2_LO = imax(TAIL_FFI1_HI, TR_L3), TAIL_GLU2_HI = imin(TAIL_GLU2_LO + CAP_G, TR_END);
constexpr int TAIL_FFI2_LO = TAIL_GLU2_HI, TAIL_FFI2_HI = imin(TAIL_FFI2_LO + CAP_F, TR_END);
constexpr int E3_LO = TAIL_FFI2_HI, E3_HI = TR_END;
constexpr int PRO_N = TR_L1 + (E1_HI - E1_LO) + (E2_HI - E2_LO) + (E3_HI - E3_LO);
__device__ __forceinline__ int pro_item(int it) {
    if (it < TR_L1) return it; it -= TR_L1;
    if (it < E1_HI - E1_LO) return E1_LO + it; it -= E1_HI - E1_LO;
    if (it < E2_HI - E2_LO) return E2_LO + it; it -= E2_HI - E2_LO;
    return E3_LO + it;
}
struct Ctx {
    const float* in[24]; unsigned char* ws;
    LAS unsigned char* lds; int tid, lane, wave, vcu, G, bx;
};

__device__ __forceinline__ void phase_prologue(const Ctx& c) {
    LAS float* scr = (LAS float*)(c.lds + c.wave * 16384);
    const int gw = c.vcu * NWAVES + c.wave, NGW = c.G * NWAVES;
#ifndef PROBE_PRO
#define PROBE_PRO 0
#endif
    for (int rpp = 0; rpp < ((PROBE_PRO & 1) ? 2 : 1); ++rpp)
    for (int it = gw; it < PRO_N; it += NGW) { const int idx = pro_item(it);
        const TrItem t = tr_decode(c.in[22], c.in[23], c.in[17], c.in[18], c.in[21], c.ws, idx);
        transpose_item(t.W, t.K, t.N, t.WT, t.kb, t.n0, t.drow0, scr, c.lane); }
    { const int gt = c.vcu * 512 + c.tid, NGT = c.G * 512; constexpr int PADV = (MLINP - MLIN) * D * 2 / 16;
        for (int i = gt; i < 2 * PADV; i += NGT) { const int l = i / PADV, v = i % PADV; *(v4u*)(c.ws + WS_WMLI + l * SZ_WMLI + (size_t)MLIN * D * 2 + (size_t)v * 16) = (v4u){0u, 0u, 0u, 0u}; } }
    __syncthreads();
    LAS float* sc = (LAS float*)c.lds;
    LAS float* red = (LAS float*)(c.lds + 40960);
    for (int i = c.tid; i < 5 * D; i += 512) { const int r = i / D, k = i % D; const float cv = r < 4 ? c.in[1][r * D + k] : c.in[3][k]; sc[i] = cv * fsigmoid(cv); }
    __syncthreads();
    const int cl = c.tid & 15, kg = c.tid >> 4;
    float* mod = (float*)(c.ws + WS_MOD);
    for (int rpa = 0; rpa < ((PROBE_PRO & 2) ? 2 : 1); ++rpa)
    for (int u = c.vcu; u < 768; u += c.G) {
        const int layer = u / 192, cb = u % 192;
        const float* W = c.in[4] + (size_t)layer * D * 6 * D + cb * 64 + cl * 4;
        float acc[5][4];
#pragma unroll
        for (int r = 0; r < 5; ++r)
#pragma unroll
            for (int e = 0; e < 4; ++e) acc[r][e] = 0.f;
#pragma unroll 8
        for (int kk = 0; kk < 64; ++kk) { const int k = kg + 32 * kk; const f32x4 w = __builtin_nontemporal_load((const f32x4*)(W + (size_t)k * (6 * D)));
#pragma unroll
            for (int r = 0; r < 5; ++r) { const float s = sc[r * D + k];
#pragma unroll
                for (int e = 0; e < 4; ++e) acc[r][e] += s * w[e]; } }
#pragma unroll
        for (int r = 0; r < 5; ++r)
#pragma unroll
            for (int e = 0; e < 4; ++e) red[(r * 4 + e) * 512 + c.tid] = acc[r][e];
        __syncthreads();
        if (c.tid < 320) { const int r = c.tid / 64, cc = c.tid % 64, cl2 = cc >> 2, e = cc & 3; float s = 0.f;
#pragma unroll 8
            for (int g = 0; g < 32; ++g) s += red[(r * 4 + e) * 512 + g * 16 + cl2];
            const int col = cb * 64 + cc; mod[(size_t)(layer * 5 + r) * 6 * D + col] = s + c.in[5][layer * 6 * D + col]; }
        __syncthreads();
    }
}

__device__ __forceinline__ void tr_issue(const TrItem& t, float (&rt)[32], int lane) {
    const float* wp = t.W + (size_t)(64 * t.kb + (lane >> 5)) * t.N + t.n0 + (lane & 31);
#pragma unroll
    for (int i = 0; i < 32; ++i) rt[i] = __builtin_nontemporal_load(wp + (size_t)(2 * i) * t.N);
}
__device__ __forceinline__ void tr_finish(const TrItem& t, const float (&rt)[32], LAS float* scr, int lane) {
#pragma unroll
    for (int i = 0; i < 32; ++i) scr[(2 * i + (lane >> 5)) * 33 + (lane & 31)] = rt[i];
    asm volatile("s_waitcnt lgkmcnt(0)" ::: "memory");
    const int cidx = lane & 7, k0 = 64 * t.kb;
#pragma unroll
    for (int j = 0; j < 4; ++j) { const int n = (lane >> 3) + 8 * j; const LAS float* s = scr + (8 * cidx) * 33 + n;
        v4u o; o.x = pk2(s[0 * 33], s[1 * 33]); o.y = pk2(s[2 * 33], s[3 * 33]); o.z = pk2(s[4 * 33], s[5 * 33]); o.w = pk2(s[6 * 33], s[7 * 33]);
        __builtin_nontemporal_store(o, (v4u*)(t.WT + (size_t)(t.drow0 + n) * t.K + k0 + 8 * cidx)); }
    asm volatile("s_waitcnt lgkmcnt(0)" ::: "memory");
}
#define TR_DEC(i_) tr_decode(c.in[22], c.in[23], c.in[17], c.in[18], c.in[21], c.ws, (i_))
__device__ __forceinline__ void tail_convert(const Ctx& c, int nunits, int lo, int hi) {
    const int nfull = nunits % c.G;
    if (nfull == 0 || c.bx < nfull || lo >= hi) return;
    LAS float* scr = (LAS float*)(c.lds + c.wave * 16384);
    const int wv = (c.bx - nfull) * NWAVES + c.wave, nwv = (c.G - nfull) * NWAVES;
    float rtA[32], rtB[32];
    int ia = lo + wv, ib = ia + nwv;
    if (ia < hi) { const TrItem t = TR_DEC(ia); tr_issue(t, rtA, c.lane); }
    if (ib < hi) { const TrItem t = TR_DEC(ib); tr_issue(t, rtB, c.lane); }
    while (ia < hi) {
        { const TrItem t = TR_DEC(ia); tr_finish(t, rtA, scr, c.lane); } ia += 2 * nwv; if (ia < hi) { const TrItem t = TR_DEC(ia); tr_issue(t, rtA, c.lane); }
        if (ib < hi) { { const TrItem t = TR_DEC(ib); tr_finish(t, rtB, scr, c.lane); } ib += 2 * nwv; if (ib < hi) { const TrItem t = TR_DEC(ib); tr_issue(t, rtB, c.lane); } }
    }
}
#undef TR_DEC

template <bool SRC32> struct NormRaw;
template <> struct NormRaw<true> { f32x4 q[8]; };
template <> struct NormRaw<false> { v2u q[8]; };
template <bool SRC32> __device__ __forceinline__ void norm_loadrow(NormRaw<SRC32>& w, const void* ctxsrc, const void* latsrc, int R, int lane) {
    if constexpr (SRC32) { const float* xr = (R < NRC ? (const float*)ctxsrc + (size_t)R * D : (const float*)latsrc + (size_t)(R - NRC) * D) + 4 * lane;
#pragma unroll
        for (int j = 0; j < 8; ++j) w.q[j] = __builtin_nontemporal_load((const f32x4*)(xr + 256 * j)); }
    else { const bf16* xr = (R < NRC ? (const bf16*)ctxsrc + (size_t)R * D : (const bf16*)latsrc + (size_t)(R - NRC) * D) + 4 * lane;
#pragma unroll
        for (int j = 0; j < 8; ++j) w.q[j] = __builtin_nontemporal_load((const v2u*)(xr + 256 * j)); }
}
template <bool SRC32> __device__ __forceinline__ f32x4 norm_cvt(const NormRaw<SRC32>& w, int j) {
    if constexpr (SRC32) return w.q[j]; else return (f32x4){bflo(w.q[j].x), bfhi(w.q[j].x), bflo(w.q[j].y), bfhi(w.q[j].y)};
}
template <bool MLP, bool SRC32> __device__ __forceinline__ void phase_norm(const Ctx& c, const void* ctxsrc, const void* latsrc, const float* g, const float* modl, int shift_idx, int scale_idx, bf16* U, const bf16* slab, bf16* Xw, int r_lo) {
    LAS float* wn = (LAS float*)c.lds; LAS float* sh = (LAS float*)(c.lds + 40960);
    __syncthreads();
    for (int i = c.tid; i < 5 * D; i += 512) { const int r = i / D, col = i % D; wn[i] = g[col] * (1.0f + modl[(size_t)(r * 6 + scale_idx) * D + col]); sh[i] = modl[(size_t)(r * 6 + shift_idx) * D + col]; }
    __syncthreads();
    const int gw = c.vcu * NWAVES + c.wave, NGW = c.G * NWAVES;
    int R = r_lo + gw;
    NormRaw<SRC32> w0, w1;
    if (R < NR) norm_loadrow<SRC32>(w0, ctxsrc, latsrc, R, c.lane);
    if (R + NGW < NR) norm_loadrow<SRC32>(w1, ctxsrc, latsrc, R + NGW, c.lane);
    while (R < NR) {
        NormRaw<SRC32> w2;
        if (R + 2 * NGW < NR) norm_loadrow<SRC32>(w2, ctxsrc, latsrc, R + 2 * NGW, c.lane);
        f32x4 v[8];
#pragma unroll
        for (int j = 0; j < 8; ++j) v[j] = norm_cvt<SRC32>(w0, j);
        int r, dstR;
        if (R < NRC) { r = 4; dstR = R;
            if (slab) {
#pragma unroll
                for (int sidx = 0; sidx < 8; ++sidx) { const bf16* sp = slab + ((size_t)sidx * NRC + R) * D + 4 * c.lane;
#pragma unroll
                    for (int j = 0; j < 8; ++j) { const v2u pw = __builtin_nontemporal_load((const v2u*)(sp + 256 * j)); v[j] += (f32x4){bflo(pw.x), bfhi(pw.x), bflo(pw.y), bfhi(pw.y)}; } }
#pragma unroll
                for (int j = 0; j < 8; ++j) { v2u xw; xw.x = pk2(v[j][0], v[j][1]); xw.y = pk2(v[j][2], v[j][3]); *(v2u*)(Xw + (size_t)R * D + 4 * c.lane + 256 * j) = xw; } } }
        else { const int q = R - NRC, s = q & 4095; r = q >> 12; dstR = MLP ? NRC + (q & ~4095) + ((s & 63) << 6) + (s >> 6) : R; }
        float ss = 0.f;
#pragma unroll
        for (int j = 0; j < 8; ++j) ss += (v[j][0] * v[j][0] + v[j][1] * v[j][1]) + (v[j][2] * v[j][2] + v[j][3] * v[j][3]);
        const float rs = 1.0f / sqrtf(wave_sum(ss) * (1.0f / D) + EPSN);
        bf16* orow = U + (size_t)dstR * D;
#pragma unroll
        for (int j = 0; j < 8; ++j) { const int col = 4 * c.lane + 256 * j; const f32x4 ww = *(const LAS f32x4*)(wn + r * D + col), hv = *(const LAS f32x4*)(sh + r * D + col);
            v2u w; w.x = pk2(v[j][0] * rs * ww[0] + hv[0], v[j][1] * rs * ww[1] + hv[1]); w.y = pk2(v[j][2] * rs * ww[2] + hv[2], v[j][3] * rs * ww[3] + hv[3]); *(v2u*)(orow + col) = w; }
        w0 = w1; w1 = w2;
        R += NGW;
    }
}
__device__ __forceinline__ void phase_final(const Ctx& c, const bf16* X, const float* g, float* out) {
    const int gw = c.vcu * NWAVES + c.wave, NGW = c.G * NWAVES;
    int q = gw; NormRaw<false> w0, w1;
    const bf16* XL = X + (size_t)NRC * D;
    if (q < NRL) norm_loadrow<false>(w0, XL, XL, NRC + q, c.lane);
    if (q + NGW < NRL) norm_loadrow<false>(w1, XL, XL, NRC + q + NGW, c.lane);
    while (q < NRL) {
        NormRaw<false> w2;
        if (q + 2 * NGW < NRL) norm_loadrow<false>(w2, XL, XL, NRC + q + 2 * NGW, c.lane);
        f32x4 v[8];
#pragma unroll
        for (int j = 0; j < 8; ++j) v[j] = norm_cvt<false>(w0, j);
        float ss = 0.f;
#pragma unroll
        for (int j = 0; j < 8; ++j) ss += (v[j][0] * v[j][0] + v[j][1] * v[j][1]) + (v[j][2] * v[j][2] + v[j][3] * v[j][3]);
        const float rs = 1.0f / sqrtf(wave_sum(ss) * (1.0f / D) + EPSN);
#pragma unroll
        for (int j = 0; j < 8; ++j) { const int col = 4 * c.lane + 256 * j; const f32x4 gg = *(const f32x4*)(g + col); __builtin_nontemporal_store(v[j] * rs * gg, (f32x4*)(out + (size_t)q * D + col)); }
        w0 = w1; w1 = w2;
        q += NGW;
    }
}

__device__ __forceinline__ int s5_rowbase(int b, int dir, int bi) {
    if (bi < 16) { const int cb = dir ? 15 - bi : bi; return b * 256 + cb * 16; }
    const int cb0 = bi - 16, cb = dir ? 255 - cb0 : cb0; return NRC + b * 4096 + cb * 16;
}
typedef float f32x16 __attribute__((ext_vector_type(16)));
__device__ __forceinline__ void phase_s5_scan3(const Ctx& c, int j, const bf16* U, bf16* YF, bf16* YB) {
    const float* lam_re = c.in[9]; const float* lam_im = c.in[10]; const float* log_dt = c.in[11];
    const float* b_re = c.in[12]; const float* b_im = c.in[13]; const float* c_re = c.in[14]; const float* c_im = c.in[15];
    const int lane = c.lane, w = c.wave, r = lane & 31, hh = lane >> 5, l15 = lane & 15, g4 = lane >> 4;
    for (int u = c.vcu; u < 256; u += c.G) {
        const int g = u >> 1, dir = u & 1;
        const size_t pg = (size_t)(j * 2 + dir) * 128 + g;
        bf16* Y = dir ? YB : YF;
        __syncthreads();
        if (w < 4) {
            const int bp = w >> 1, sg = w & 1, p = 32 * sg + r, bme = 2 * bp + hh;
            const float dt = expf(log_dt[pg]);
            const float lre = lam_re[pg * 64 + p], lim = lam_im[pg * 64 + p];
            const float mag = expf(lre * dt); float sn, cs; sincosf(lim * dt, &sn, &cs);
            const float are = mag * cs, aim = mag * sn;
            const float den = lre * lre + lim * lim;
            const float fre = ((are - 1.0f) * lre + aim * lim) / den, fim = (aim * lre - (are - 1.0f) * lim) / den;
            bf16x8 Bfr, Bfi;
            { const f32x4 br0 = *(const f32x4*)(b_re + (pg * 64 + p) * 16 + 8 * hh), br1 = *(const f32x4*)(b_re + (pg * 64 + p) * 16 + 8 * hh + 4);
              const f32x4 bi0 = *(const f32x4*)(b_im + (pg * 64 + p) * 16 + 8 * hh), bi1 = *(const f32x4*)(b_im + (pg * 64 + p) * 16 + 8 * hh + 4);
#pragma unroll
              for (int e = 0; e < 4; ++e) { Bfr[e] = (short)f2bf(fre * br0[e] - fim * bi0[e]); Bfr[4 + e] = (short)f2bf(fre * br1[e] - fim * bi1[e]);
                  Bfi[e] = (short)f2bf(fre * bi0[e] + fim * br0[e]); Bfi[4 + e] = (short)f2bf(fre * bi1[e] + fim * br1[e]); } }
            const int hrow = (r >> 2) & 1, tst = 4 * (r >> 3) + (r & 3), toff = dir ? 15 - tst : tst, brow = 2 * bp + hrow;
            const bf16* up = U + (size_t)g * 16 + 8 * hh;
            bf16x8 ring[8];
#pragma unroll
            for (int k = 0; k < 8; ++k) ring[k] = *(const bf16x8*)(up + (size_t)(s5_rowbase(brow, dir, k) + toff) * D);
            float sre = 0.f, sim = 0.f;
            f32x16 z;
#pragma unroll
            for (int e = 0; e < 16; ++e) z[e] = 0.f;
            f32x16 hrn = __builtin_amdgcn_mfma_f32_32x32x16_bf16(ring[0], Bfr, z, 0, 0, 0), hin = __builtin_amdgcn_mfma_f32_32x32x16_bf16(ring[0], Bfi, z, 0, 0, 0);
            ring[0] = *(const bf16x8*)(up + (size_t)(s5_rowbase(brow, dir, 8) + toff) * D);
            const int sg16 = dir ? -16 : 16, dS = NRC + brow * 3840 + (dir ? 4080 : -240);
            const bf16* upn = up + (size_t)(s5_rowbase(brow, dir, 9) + toff) * D; int nb = 9;
            for (int bb = 0; bb < 272; bb += 8) {
#pragma unroll
              for (int k = 0; k < 8; ++k) {
                const int bi = bb + k;
                const f32x16 hr = hrn, hi = hin;
                { const int kn = (k + 1) & 7; const bf16x8 unx = ring[kn];
                  hrn = __builtin_amdgcn_mfma_f32_32x32x16_bf16(unx, Bfr, z, 0, 0, 0); hin = __builtin_amdgcn_mfma_f32_32x32x16_bf16(unx, Bfi, z, 0, 0, 0);
                  ring[kn] = *(const bf16x8*)upn;
                  if (nb < 271) { const long dr = nb == 15 ? dS : sg16; upn += dr * D; ++nb; } }
                LAS unsigned char* hb = c.lds + (bme * 2 + ((bi >> 1) & 1)) * 8704 + (bi & 1) * 4352 + 4 * p;
#pragma unroll
                for (int e = 0; e < 16; ++e) { float nre = fmaf(are, sre, fmaf(-aim, sim, hr[e])); asm volatile("" : "+v"(nre));
                    const float nim = fmaf(are, sim, fmaf(aim, sre, hi[e])); sre = nre; sim = nim;
                    *(LAS unsigned*)(hb + e * 272) = pg8::cvt_pk_bf16(nre, nim); }
                if (k & 1) __syncthreads();
              }
            }
        } else {
            const int bq = w - 4;
            bf16x8 Cf[4];
#pragma unroll
            for (int ks = 0; ks < 4; ++ks) { const int p0 = 16 * ks + 4 * g4; const f32x4 cr = *(const f32x4*)(c_re + (pg * 16 + l15) * 64 + p0), ci = *(const f32x4*)(c_im + (pg * 16 + l15) * 64 + p0);
#pragma unroll
                for (int e = 0; e < 4; ++e) { Cf[ks][2 * e] = (short)f2bf(cr[e]); Cf[ks][2 * e + 1] = (short)f2bf(-ci[e]); } }
            const int sg16 = dir ? -16 : 16, dS = NRC + bq * 3840 + (dir ? 4080 : -240);
            bf16* yp = Y + (size_t)(s5_rowbase(bq, dir, 0) + (dir ? 15 - l15 : l15)) * D + g * 16 + 4 * g4;
            for (int bp2 = 0; bp2 < 136; ++bp2) {
                __syncthreads();
#pragma unroll
                for (int hf2 = 0; hf2 < 2; ++hf2) {
                    const int bi = 2 * bp2 + hf2;
                    const LAS unsigned char* hb = c.lds + (bq * 2 + (bp2 & 1)) * 8704 + hf2 * 4352;
                    f32x4 acc = {0.f, 0.f, 0.f, 0.f};
#pragma unroll
                    for (int ks = 0; ks < 4; ++ks) { const bf16x8 hf = *(const LAS bf16x8*)(hb + l15 * 272 + ks * 64 + g4 * 16);
                        acc = __builtin_amdgcn_mfma_f32_16x16x32_bf16(Cf[ks], hf, acc, 0, 0, 0); }
                    *(v2u*)yp = (v2u){pg8::cvt_pk_bf16(acc[0], acc[1]), pg8::cvt_pk_bf16(acc[2], acc[3])};
                    { const long dr = bi == 15 ? dS : sg16; yp += dr * D; }
                }
            }
        }
    }
}

__device__ __forceinline__ v4u s5_comb_item(v4u uw, v4u fw, v4u bw, f32x4 d0, f32x4 d1) {
    float y[8];
    y[0] = d0[0] * bflo(uw.x) + bflo(fw.x) + bflo(bw.x); y[1] = d0[1] * bfhi(uw.x) + bfhi(fw.x) + bfhi(bw.x); y[2] = d0[2] * bflo(uw.y) + bflo(fw.y) + bflo(bw.y); y[3] = d0[3] * bfhi(uw.y) + bfhi(fw.y) + bfhi(bw.y);
    y[4] = d1[0] * bflo(uw.z) + bflo(fw.z) + bflo(bw.z); y[5] = d1[1] * bfhi(uw.z) + bfhi(fw.z) + bfhi(bw.z); y[6] = d1[2] * bflo(uw.w) + bflo(fw.w) + bflo(bw.w); y[7] = d1[3] * bfhi(uw.w) + bfhi(fw.w) + bfhi(bw.w);
#pragma unroll
    for (int e = 0; e < 8; ++e) { const float x = y[e]; const float z = 0.7978845608028654f * (x + 0.044715f * x * x * x); y[e] = x * fsigmoid(2.0f * z); }
    v4u w; w.x = pk2(y[0], y[1]); w.y = pk2(y[2], y[3]); w.z = pk2(y[4], y[5]); w.w = pk2(y[6], y[7]); return w;
}
__device__ __forceinline__ void phase_s5_combine(const Ctx& c, const float* dsk, const bf16* U, const bf16* YF, const bf16* YB, bf16* Gout) {
    const int gt = c.vcu * 512 + c.tid, NGT = c.G * 512; constexpr int NIT = NR * (D / 8);
    for (int i = gt; i < NIT; i += 2 * NGT) {
        const int i1 = i + NGT; const bool has1 = i1 < NIT;
        const size_t o0 = (size_t)i * 8, o1 = (size_t)(has1 ? i1 : i) * 8; const int c0 = (int)(o0 & (D - 1)), c1 = (int)(o1 & (D - 1));
        const v4u u0 = __builtin_nontemporal_load((const v4u*)(U + o0)), f0 = __builtin_nontemporal_load((const v4u*)(YF + o0)), b0 = __builtin_nontemporal_load((const v4u*)(YB + o0)),
                  u1 = __builtin_nontemporal_load((const v4u*)(U + o1)), f1 = __builtin_nontemporal_load((const v4u*)(YF + o1)), b1 = __builtin_nontemporal_load((const v4u*)(YB + o1));
        const f32x4 d00 = *(const f32x4*)(dsk + c0), d01 = *(const f32x4*)(dsk + c0 + 4), d10 = *(const f32x4*)(dsk + c1), d11 = *(const f32x4*)(dsk + c1 + 4);
        const v4u w0 = s5_comb_item(u0, f0, b0, d00, d01), w1 = s5_comb_item(u1, f1, b1, d10, d11);
        *(v4u*)(Gout + o0) = w0; if (has1) *(v4u*)(Gout + o1) = w1;
    }
}

typedef short s16x4 __attribute__((ext_vector_type(4)));
__device__ __forceinline__ bf16x8 tr_frag(LAS unsigned char* p0, LAS unsigned char* p1) {
    const s16x4 a = __builtin_amdgcn_ds_read_tr16_b64_v4i16((LAS s16x4*)p0), b = __builtin_amdgcn_ds_read_tr16_b64_v4i16((LAS s16x4*)p1);
    return __builtin_shufflevector(a, b, 0, 1, 2, 3, 4, 5, 6, 7);
}
__device__ __forceinline__ float fexp(float x) { return __builtin_amdgcn_exp2f(1.4426950408889634f * x); }
__device__ __forceinline__ int mlc_rowbase(int b, int dir, int cc) {
    if (cc < 4) { const int nc = dir ? 3 - cc : cc; return b * 256 + 64 * nc; }
    const int n0 = cc - 4, nc = dir ? 63 - n0 : n0; return NRC + b * 4096 + 64 * nc;
}
#define DPP_F(oldv, src, ctrl, rmask) __builtin_bit_cast(float, __builtin_amdgcn_update_dpp(__builtin_bit_cast(int, (float)(oldv)), __builtin_bit_cast(int, (float)(src)), (ctrl), (rmask), 0xf, false))
__device__ __forceinline__ float wave_scan_add(float x) {
    x += DPP_F(0.f, x, 0x111, 0xf); x += DPP_F(0.f, x, 0x112, 0xf); x += DPP_F(0.f, x, 0x114, 0xf); x += DPP_F(0.f, x, 0x118, 0xf);
    x += DPP_F(0.f, x, 0x142, 0xa); x += DPP_F(0.f, x, 0x143, 0xc); return x; }
__device__ __forceinline__ float wave_scan_max(float x) {
    const float NI = -__builtin_inff();
    x = fmaxf(x, DPP_F(NI, x, 0x111, 0xf)); x = fmaxf(x, DPP_F(NI, x, 0x112, 0xf)); x = fmaxf(x, DPP_F(NI, x, 0x114, 0xf)); x = fmaxf(x, DPP_F(NI, x, 0x118, 0xf));
    x = fmaxf(x, DPP_F(NI, x, 0x142, 0xa)); x = fmaxf(x, DPP_F(NI, x, 0x143, 0xc)); return x; }
__device__ __forceinline__ void phase_mlstm_chunk2(const Ctx& c, const bf16* Q, const bf16* K, const bf16* V, const float* GATES, bf16* HF, bf16* HB) {
    constexpr int QS = 0, KS = 17408, KWS = 34816  , VS = 69632  , PS = 87040, CB = 96256, NV = 113664, QN = 114176, GL = 114432  , NP = 115456  , PRIV = 119552;
    static_assert(PRIV + 8 * 1280 <= RING_BYTES && NP + 8 * 128 * 4 <= PRIV, "mLSTM chunk LDS map");
    LAS unsigned char* L = c.lds;
    const int tid = c.tid, lane = c.lane, w = c.wave, l15 = lane & 15, g4 = lane >> 4, qq = l15 >> 2, pp = l15 & 3;
    const int et = w & 3, ih = w >> 2;
    LAS float* priv = (LAS float*)(L + PRIV + w * 1280);
    const int srow = tid >> 3, spc = tid & 7;
    bf16x8 ones;
#pragma unroll
    for (int e = 0; e < 8; ++e) ones[e] = (short)0x3F80;
    for (int u = c.vcu; u < 256; u += c.G) {
        const int es = u & 3, dir = (u >> 2) & 1, h = (u >> 3) & 7, b = u >> 6;
        bf16* HOUT = dir ? HB : HF;
        __syncthreads();
        for (int i = tid; i < 17408 / 4; i += 512) ((LAS unsigned*)(L + CB))[i] = 0u;
        if (tid < 128) ((LAS float*)(L + NV))[tid] = 0.f;
        f32x4 Cacc[4];
#pragma unroll
        for (int j = 0; j < 4; ++j) Cacc[j] = (f32x4){0.f, 0.f, 0.f, 0.f};
        float m = 0.f;
        v4u rq0, rq1, rk0, rk1, rv; float rg = 0.f;
        const int sgn64 = dir ? -64 : 64, dB = NRC + b * 3840 + (dir ? 4032 : -192);
        int lc = 0, gc = 0;
        const bf16 *qp, *kp, *vp; const float* gp; bf16* hp[2];
        { const size_t R0_ = (size_t)(mlc_rowbase(b, dir, 0) + (dir ? 63 - srow : srow)); qp = Q + R0_ * 1024 + h * 128 + spc * 16; kp = K + R0_ * 1024 + h * 128 + spc * 16; vp = V + R0_ * D + h * 256 + es * 64 + spc * 8;
          const int s_ = tid & 63, wh_ = (tid >> 6) & 1; gp = GATES + (size_t)(mlc_rowbase(b, dir, 0) + (dir ? 63 - s_ : s_)) * 32 + (2 * dir + wh_) * 8 + h;
#pragma unroll
          for (int t = 0; t < 2; ++t) { const int i = 16 * (2 * ih + t) + l15; hp[t] = HOUT + (size_t)(mlc_rowbase(b, dir, 0) + (dir ? 63 - i : i)) * D + h * 256 + es * 64 + 16 * et + 4 * g4; } }
#define MLC_LOAD(cc_) do { rq0 = *(const v4u*)qp; rq1 = *(const v4u*)(qp + 8); rk0 = *(const v4u*)kp; rk1 = *(const v4u*)(kp + 8); rv = *(const v4u*)vp; \
            const long dr_ = (lc == 3) ? dB : sgn64; qp += dr_ * 1024; kp += dr_ * 1024; vp += dr_ * D; ++lc; } while (0)
#define MLC_LOADG(cc_) do { if (tid < 128) rg = *gp; const long dr_ = (gc == 3) ? dB : sgn64; gp += dr_ * 32; ++gc; } while (0)
#define MLC_STOREG(buf_) do { if (tid < 128) ((LAS float*)(L + GL + (buf_) * 512))[tid] = rg; } while (0)
        MLC_LOADG(0); MLC_STOREG(0); MLC_LOADG(1);
        MLC_LOAD(0);
        __syncthreads();
        float decay = 0.f, wgr_n = 0.f; v4u ck0 = {0u, 0u, 0u, 0u}, ck1 = {0u, 0u, 0u, 0u};
        auto secA = [&](const int cn) __attribute__((always_inline)) {
            const int db = cn & 1;
            LAS unsigned char* KWb = L + KWS + db * 17408; LAS unsigned char* Vb_ = L + VS + db * 8704;
            *(LAS v4u*)(L + QS + srow * 272 + spc * 32) = rq0; *(LAS v4u*)(L + QS + srow * 272 + spc * 32 + 16) = rq1;
            *(LAS v4u*)(L + KS + srow * 272 + spc * 32) = rk0; *(LAS v4u*)(L + KS + srow * 272 + spc * 32 + 16) = rk1;
            *(LAS v2u*)(Vb_ + srow * 136 + spc * 16) = (v2u){rv.x, rv.y}; *(LAS v2u*)(Vb_ + srow * 136 + spc * 16 + 8) = (v2u){rv.z, rv.w};
            ck0 = rk0; ck1 = rk1;
            MLC_STOREG(db ^ 1);
            if (cn + 1 < 68) MLC_LOAD(cn + 1);
            if (cn + 2 < 68) MLC_LOADG(cn + 2);
            { const float li = ((LAS float*)(L + GL + db * 512))[lane], lf = ((LAS float*)(L + GL + db * 512))[64 + lane];
                const float bc = wave_scan_add(lf);
                const float a = li - bc; const float pm = wave_scan_max(a);
                const float M = fmaxf(m, pm);
                const float M63 = __builtin_bit_cast(float, __builtin_amdgcn_readlane(__builtin_bit_cast(int, M), 63)), b63 = __builtin_bit_cast(float, __builtin_amdgcn_readlane(__builtin_bit_cast(int, bc), 63));
                priv[lane] = a; priv[64 + lane] = -M; priv[128 + lane] = fexp(m - M); priv[192 + lane] = fexp(-bc - M); priv[256 + lane] = fexp(a - M63);
                decay = fexp(m - M63); m = b63 + M63; }
            wgr_n = priv[256 + srow];
        };
        auto secA2 = [&](const int cn) __attribute__((always_inline)) {
            const int db = cn & 1;
            LAS unsigned char* KWb = L + KWS + db * 17408;
            { const float wgr = wgr_n;
                v4u k0, k1;
                k0.x = pg8::cvt_pk_bf16(bflo(ck0.x) * wgr, bfhi(ck0.x) * wgr); k0.y = pg8::cvt_pk_bf16(bflo(ck0.y) * wgr, bfhi(ck0.y) * wgr); k0.z = pg8::cvt_pk_bf16(bflo(ck0.z) * wgr, bfhi(ck0.z) * wgr); k0.w = pg8::cvt_pk_bf16(bflo(ck0.w) * wgr, bfhi(ck0.w) * wgr);
                k1.x = pg8::cvt_pk_bf16(bflo(ck1.x) * wgr, bfhi(ck1.x) * wgr); k1.y = pg8::cvt_pk_bf16(bflo(ck1.y) * wgr, bfhi(ck1.y) * wgr); k1.z = pg8::cvt_pk_bf16(bflo(ck1.z) * wgr, bfhi(ck1.z) * wgr); k1.w = pg8::cvt_pk_bf16(bflo(ck1.w) * wgr, bfhi(ck1.w) * wgr);
                *(LAS v4u*)(KWb + srow * 272 + spc * 32) = k0; *(LAS v4u*)(KWb + srow * 272 + spc * 32 + 16) = k1; }
        };
        secA(0); secA2(0);
        __syncthreads();
        for (int cc = 0; cc < 68; ++cc) {
            const int db = cc & 1;
            LAS unsigned char* KWb = L + KWS + db * 17408; LAS unsigned char* Vb_ = L + VS + db * 8704;
            bf16x8 qf[2][4];
            f32x4 oacc[2];
            {
#pragma unroll
                for (int t = 0; t < 2; ++t)
#pragma unroll
                    for (int ks = 0; ks < 4; ++ks) qf[t][ks] = *(const LAS bf16x8*)(L + QS + (16 * (2 * ih + t) + l15) * 272 + ks * 64 + g4 * 16);
                f32x4 sacc[2] = {(f32x4){0.f, 0.f, 0.f, 0.f}, (f32x4){0.f, 0.f, 0.f, 0.f}};
#pragma unroll
                for (int ks = 0; ks < 4; ++ks) { const bf16x8 kf = *(const LAS bf16x8*)(L + KS + (16 * et + l15) * 272 + ks * 64 + g4 * 16);
                    sacc[0] = __builtin_amdgcn_mfma_f32_16x16x32_bf16(kf, qf[0][ks], sacc[0], 0, 0, 0); sacc[1] = __builtin_amdgcn_mfma_f32_16x16x32_bf16(kf, qf[1][ks], sacc[1], 0, 0, 0); }
                oacc[0] = (f32x4){0.f, 0.f, 0.f, 0.f}; oacc[1] = (f32x4){0.f, 0.f, 0.f, 0.f};
#pragma unroll
                for (int ks = 0; ks < 4; ++ks) { const bf16x8 cf = *(const LAS bf16x8*)(L + CB + (16 * et + l15) * 272 + ks * 64 + g4 * 16);
                    oacc[0] = __builtin_amdgcn_mfma_f32_16x16x32_bf16(cf, qf[0][ks], oacc[0], 0, 0, 0); oacc[1] = __builtin_amdgcn_mfma_f32_16x16x32_bf16(cf, qf[1][ks], oacc[1], 0, 0, 0); }
                const f32x4 av = *(const LAS f32x4*)(priv + 16 * et + 4 * g4);
#pragma unroll
                for (int t = 0; t < 2; ++t) { const int i = 16 * (2 * ih + t) + l15; const float negM = priv[64 + i]; float pv4[4];
#pragma unroll
                    for (int r = 0; r < 4; ++r) { const int s = 16 * et + 4 * g4 + r; const float wgt = (s <= i) ? fexp(av[r] + negM) : 0.f; pv4[r] = sacc[t][r] * wgt; }
                    *(LAS v2u*)(L + PS + i * 144 + (16 * et + 4 * g4) * 2) = (v2u){pg8::cvt_pk_bf16(pv4[0], pv4[1]), pg8::cvt_pk_bf16(pv4[2], pv4[3])};
                    oacc[t] = oacc[t] * priv[128 + i]; }
                { const v4u a0 = *(const LAS v4u*)(L + QS + srow * 272 + spc * 32), a1 = *(const LAS v4u*)(L + QS + srow * 272 + spc * 32 + 16);
                    const LAS f32x4* np = (const LAS f32x4*)(L + NV + spc * 64); const f32x4 n0 = np[0], n1 = np[1], n2 = np[2], n3 = np[3];
                    float d = bflo(a0.x) * n0[0] + bfhi(a0.x) * n0[1] + bflo(a0.y) * n0[2] + bfhi(a0.y) * n0[3] + bflo(a0.z) * n1[0] + bfhi(a0.z) * n1[1] + bflo(a0.w) * n1[2] + bfhi(a0.w) * n1[3]
                            + bflo(a1.x) * n2[0] + bfhi(a1.x) * n2[1] + bflo(a1.y) * n2[2] + bfhi(a1.y) * n2[3] + bflo(a1.z) * n3[0] + bfhi(a1.z) * n3[1] + bflo(a1.w) * n3[2] + bfhi(a1.w) * n3[3];
                    d += DPP_F(0.f, d, 0xB1, 0xf); d += DPP_F(0.f, d, 0x4E, 0xf); d += DPP_F(0.f, d, 0x141, 0xf);
                    if (spc == 0) ((LAS float*)(L + QN))[srow] = d; }
                if (tid < 256) { const int d4 = tid & 31, rg8 = tid >> 5; f32x4 sm = {0.f, 0.f, 0.f, 0.f};
#pragma unroll
                    for (int s = 0; s < 8; ++s) { const v2u kv = *(const LAS v2u*)(KWb + (8 * rg8 + s) * 272 + d4 * 8); sm[0] += bflo(kv.x); sm[1] += bfhi(kv.x); sm[2] += bflo(kv.y); sm[3] += bfhi(kv.y); }
                    *(LAS f32x4*)(L + NP + (rg8 * 128 + 4 * d4) * 4) = sm; }
            }
            __syncthreads();
            const float dec_c = decay;
            float e128[2], e192[2], qnv[2];
#pragma unroll
            for (int t = 0; t < 2; ++t) { const int i = 16 * (2 * ih + t) + l15; e128[t] = priv[128 + i]; e192[t] = priv[192 + i]; qnv[t] = ((LAS float*)(L + QN))[i]; }
            secA(cc + 1);
            {
                bf16x8 vf[2];
#pragma unroll
                for (int ks = 0; ks < 2; ++ks) { LAS unsigned char* vp = Vb_ + (32 * ks + 8 * g4 + qq) * 136 + (16 * et + 4 * pp) * 2; vf[ks] = tr_frag(vp, vp + 4 * 136); }
                f32x4 racc[2] = {(f32x4){0.f, 0.f, 0.f, 0.f}, (f32x4){0.f, 0.f, 0.f, 0.f}};
#pragma unroll
                for (int ks = 0; ks < 2; ++ks)
#pragma unroll
                    for (int t = 0; t < 2; ++t) { const bf16x8 pf = *(const LAS bf16x8*)(L + PS + (16 * (2 * ih + t) + l15) * 144 + ks * 64 + g4 * 16);
                        oacc[t] = __builtin_amdgcn_mfma_f32_16x16x32_bf16(vf[ks], pf, oacc[t], 0, 0, 0); racc[t] = __builtin_amdgcn_mfma_f32_16x16x32_bf16(ones, pf, racc[t], 0, 0, 0); }
#pragma unroll
                for (int t = 0; t < 2; ++t) { const int i = 16 * (2 * ih + t) + l15;
                    const float den = e128[t] * qnv[t] + racc[t][0];
                    const float inv = __builtin_amdgcn_rcpf(fmaxf(fabsf(den), e192[t]));
                    const f32x4 ho = oacc[t] * inv; *(v2u*)hp[t] = (v2u){pg8::cvt_pk_bf16(ho[0], ho[1]), pg8::cvt_pk_bf16(ho[2], ho[3])}; }
                { const long dr_ = (cc == 3) ? dB : sgn64; hp[0] += dr_ * D; hp[1] += dr_ * D; }
#pragma unroll
                for (int j = 0; j < 4; ++j) Cacc[j] = Cacc[j] * dec_c;
#pragma unroll
                for (int ks = 0; ks < 2; ++ks)
#pragma unroll
                    for (int j = 0; j < 4; ++j) { LAS unsigned char* kp = KWb + (32 * ks + 8 * g4 + qq) * 272 + (16 * (4 * ih + j) + 4 * pp) * 2; const bf16x8 kwf = tr_frag(kp, kp + 4 * 272);
                        Cacc[j] = __builtin_amdgcn_mfma_f32_16x16x32_bf16(kwf, vf[ks], Cacc[j], 0, 0, 0); }
#pragma unroll
                for (int j = 0; j < 4; ++j)
                    *(LAS v2u*)(L + CB + (16 * et + l15) * 272 + (16 * (4 * ih + j) + 4 * g4) * 2) = (v2u){pg8::cvt_pk_bf16(Cacc[j][0], Cacc[j][1]), pg8::cvt_pk_bf16(Cacc[j][2], Cacc[j][3])};
                if (tid < 128) { LAS float* np = (LAS float*)(L + NP) + tid; LAS float* nv = (LAS float*)(L + NV);
                    float x0 = np[0], x1 = np[128], x2 = np[256], x3 = np[384], x4 = np[512], x5 = np[640], x6 = np[768], x7 = np[896], x8 = nv[tid];
                    asm volatile("" : "+v"(x0), "+v"(x1), "+v"(x2), "+v"(x3), "+v"(x4), "+v"(x5), "+v"(x6), "+v"(x7), "+v"(x8));
                    nv[tid] = dec_c * x8 + (((x0 + x1) + (x2 + x3)) + ((x4 + x5) + (x6 + x7))); }
            }
            secA2(cc + 1);
            __syncthreads();
        }
#undef MLC_LOAD
#undef MLC_LOADG
#undef MLC_STOREG
    }
}

__device__ __forceinline__ void phase_ml_readout(const Ctx& c, const bf16* HF, const bf16* HB, const bf16* O, const float* nw, bf16* Gout, int r_lo) {
    const int gw = c.vcu * NWAVES + c.wave, NGW = c.G * NWAVES;
    for (int R = r_lo + gw; R < NR; R += NGW) {
        int dstR = R;
        if (R >= NRC) { const int q = R - NRC, pq = q & 4095; dstR = NRC + (q & ~4095) + ((pq & 63) << 6) + (pq >> 6); }
        v2u hfw[8], hbw[8], ow[8];
#pragma unroll
        for (int j = 0; j < 8; ++j) { const size_t off = (size_t)R * D + 256 * j + 4 * c.lane; hfw[j] = __builtin_nontemporal_load((const v2u*)(HF + off)); hbw[j] = __builtin_nontemporal_load((const v2u*)(HB + off)); ow[j] = __builtin_nontemporal_load((const v2u*)(O + off)); }
        asm volatile("" ::: "memory");
#pragma unroll
        for (int j = 0; j < 8; ++j) {
            const f32x4 hs = (f32x4){bflo(hfw[j].x), bfhi(hfw[j].x), bflo(hfw[j].y), bfhi(hfw[j].y)} + (f32x4){bflo(hbw[j].x), bfhi(hbw[j].x), bflo(hbw[j].y), bfhi(hbw[j].y)};
            const float ss = wave_sum((hs[0] * hs[0] + hs[1] * hs[1]) + (hs[2] * hs[2] + hs[3] * hs[3]));
            const float rs = 1.0f / sqrtf(ss * (1.0f / 256.0f) + EPSN);
            const f32x4 w4 = *(const f32x4*)(nw + 256 * j + 4 * c.lane);
            const float o0 = hs[0] * rs * w4[0] * fsigmoid(bflo(ow[j].x)), o1 = hs[1] * rs * w4[1] * fsigmoid(bfhi(ow[j].x)), o2 = hs[2] * rs * w4[2] * fsigmoid(bflo(ow[j].y)), o3 = hs[3] * rs * w4[3] * fsigmoid(bfhi(ow[j].y));
            v2u w; w.x = pk2(o0, o1); w.y = pk2(o2, o3); *(v2u*)(Gout + (size_t)dstR * D + 256 * j + 4 * c.lane) = w; }
    }
}

struct Args { const float* in[24]; float* out; unsigned char* ws; int ph_lo, ph_hi; };
constexpr int NPHASES = 1 + 2 * 7 + 2 * 8 + 1;
typedef const float* fptr_t;
#ifndef PHSEL
#define PHSEL 0xffffffffu
#endif
__global__ void __launch_bounds__(NWAVES * 64, 2) mk_fwd(Args args) {
    extern __shared__ __attribute__((aligned(16))) unsigned char lds_raw[];
    LAS unsigned char* const lds = (LAS unsigned char*)lds_raw;
    int wave_s = __builtin_amdgcn_readfirstlane((int)threadIdx.x >> 6); asm volatile("" : "+s"(wave_s));
    { const int tid0 = wave_s * 64 + mk_lane();
      for (int u = tid0; u < (LDS_BYTES - LDSCTL_OFF) / 4; u += NWAVES * 64) ((LAS unsigned*)(lds + LDSCTL_OFF))[u] = 0u; }
    __syncthreads();
    volatile LAS unsigned* MISC = (volatile LAS unsigned*)(lds + MISC_OFF);
    XcdBarrier bar; bar.bar = (unsigned*)(args.ws + WS_CTL) + CW_BAR; bar.x = 0; bar.st = nullptr;
    if (MK_ONE_LAUNCH) bar = xcd_barrier_post((unsigned*)(args.ws + WS_CTL) + CW_BAR, MISC + 8, wave_s);
    const int lo = args.ph_lo, hi = args.ph_hi;
    int pc = 0;
#ifndef PROBE_DUP
#define PROBE_DUP 0u
#endif
#define PH_BEGIN(id) if (pc >= lo && pc < hi && (PHSEL & (1u << (id)))) for (int rep_ = ((PROBE_DUP & (1u << (id))) ? 1 : 0); rep_ >= 0; --rep_) { __syncthreads(); \
        const __attribute__((address_space(4))) fptr_t* inl = (const __attribute__((address_space(4))) fptr_t*)__builtin_amdgcn_kernarg_segment_ptr(); asm volatile("" : "+s"(inl)); \
        Ctx c; _Pragma("unroll") for (int i_ = 0; i_ < 24; ++i_) c.in[i_] = inl[i_]; c.ws = (unsigned char*)inl[25]; float* const outp = (float*)inl[24]; (void)outp; \
        int tid_ = wave_s * 64 + mk_lane(); asm volatile("" : "+v"(tid_)); int bx_ = blockIdx.x; asm volatile("" : "+s"(bx_)); int G_ = gridDim.x; asm volatile("" : "+s"(G_)); \
        c.lds = lds; c.tid = tid_; c.lane = c.tid & 63; c.wave = __builtin_amdgcn_readfirstlane(c.tid >> 6); \
        c.G = G_; c.bx = bx_; c.vcu = (c.G % 8 == 0) ? (bx_ % 8) * (c.G / 8) + bx_ / 8 : bx_; \
        bf16* const X = (bf16*)(c.ws + WS_X); bf16* const U = (bf16*)(c.ws + WS_U); bf16* const Gb = (bf16*)(c.ws + WS_G); bf16* const HID = (bf16*)(c.ws + WS_HID); \
        float* const TA0 = (float*)(c.ws + WS_TA); float* const TA1 = (float*)(c.ws + WS_TA + SZ_F32ROWS); \
        bf16* const Qb = (bf16*)(c.ws + WS_Q); bf16* const Kb = (bf16*)(c.ws + WS_K); bf16* const Vb = (bf16*)(c.ws + WS_V); bf16* const Ob = (bf16*)(c.ws + WS_O); float* const GATES = (float*)(c.ws + WS_GATES); \
        const int j = layer >> 1; const float* const modl = (const float*)(c.ws + WS_MOD) + (size_t)layer * 5 * 6 * D; \
        const void* const ctxsrc = layer == 0 ? (const void*)c.in[2] : (const void*)X; const void* const latsrc = layer == 0 ? (const void*)c.in[0] : (const void*)(X + (size_t)NRC * D); \
        (void)X; (void)U; (void)Gb; (void)HID; (void)TA0; (void)TA1; (void)Qb; (void)Kb; (void)Vb; (void)Ob; (void)GATES; (void)j; (void)modl; (void)ctxsrc; (void)latsrc;
#ifndef PROBE_XBAR
#define PROBE_XBAR 0
#endif
#define PH_END } if (MK_ONE_LAUNCH && pc >= lo && pc + 1 < hi) { xcd_barrier(bar, wave_s); if (PROBE_XBAR) xcd_barrier(bar, wave_s); } ++pc;

    int layer = 0;
    PH_BEGIN(0) phase_prologue(c); PH_END

    for (layer = 0; layer < DEPTH; ++layer) {
        if ((layer & 1) == 0) {
            PH_BEGIN(1) if (layer == 0) phase_norm<false, true>(c, ctxsrc, latsrc, c.in[6] + layer * D, modl, 0, 1, U, nullptr, X, 0); else phase_norm<false, false>(c, ctxsrc, latsrc, c.in[6] + layer * D, modl, 0, 1, U, rep_ ? nullptr : (const bf16*)TA0, X, 0); PH_END
            PH_BEGIN(2) phase_s5_scan3(c, j, U, (bf16*)TA0, (bf16*)TA1); PH_END
            PH_BEGIN(3) phase_s5_combine(c, c.in[16] + j * D, U, (const bf16*)TA0, (const bf16*)TA1, Gb); PH_END
            PH_BEGIN(4) { pg8::Gemm g{Gb, (const bf16*)(c.ws + WS_WGLU + j * SZ_WGLU), NR, 2 * D, D}; pg8::StaticOrder S; S.init(NR, 2 * D, c.G, c.bx, D);
                EpiGlu E{c.in[2], c.in[0], X, modl, 0, layer == 0}; pg8::gemm_phase<EpiGlu, pg8::StaticOrder, true, true>(c.lds, g, S, E, c.tid);
                if (rep_ == 0) tail_convert(c, (NR / 256) * (2 * D / 256), layer == 0 ? TAIL_GLU0_LO : TAIL_GLU2_LO, layer == 0 ? TAIL_GLU0_HI : TAIL_GLU2_HI); } PH_END
        } else {
            PH_BEGIN(5) phase_norm<true, false>(c, ctxsrc, latsrc, c.in[6] + layer * D, modl, 0, 1, U, rep_ ? nullptr : (const bf16*)TA0, X, 0); PH_END
            PH_BEGIN(6) { pg8::Gemm g{U, (const bf16*)(c.ws + WS_WMLI + j * SZ_WMLI), NR, MLINP, D}; pg8::StaticOrder S; S.init(NR, MLINP, c.G, c.bx, D);
                EpiMli E{Qb, Kb, Vb, Ob, GATES, c.in[19] + j * 32}; pg8::gemm_phase<EpiMli, pg8::StaticOrder, true, true>(c.lds, g, S, E, c.tid);
                if (rep_ == 0 && layer == 1) tail_convert(c, (NR / 256) * (MLINP / 256), TAIL_MLI1_LO, TAIL_MLI1_HI); } PH_END
            PH_BEGIN(7) phase_mlstm_chunk2(c, Qb, Kb, Vb, GATES, (bf16*)TA0, (bf16*)TA1); PH_END
            PH_BEGIN(8) phase_ml_readout(c, (const bf16*)TA0, (const bf16*)TA1, Ob, c.in[20] + j * D, Gb, layer == 3 ? NRC : 0); PH_END
            PH_BEGIN(9) { pg8::Gemm g{Gb, (const bf16*)(c.ws + WS_WMLO + j * SZ_WMLO), NR, D, D}; ResCtxOrder S; S.init(c.G, c.bx, D, layer == 1, 4, 8);
                EpiResSlab E{X, (bf16*)TA0, modl, 2}; pg8::gemm_phase<EpiResSlab, ResCtxOrder, true, true>(c.lds, g, S, E, c.tid); } PH_END
        }
        PH_BEGIN(10) phase_norm<false, false>(c, X, X + (size_t)NRC * D, c.in[7] + layer * D, modl, 3, 4, U, (layer == 1 && rep_ == 0) ? (const bf16*)TA0 : nullptr, X, layer == 3 ? NRC : 0); PH_END
        PH_BEGIN(11) { const int pm0 = layer == 3 ? 4 : 0; pg8::Gemm g{U + (size_t)pm0 * 256 * D, (const bf16*)(c.ws + WS_WFFI + layer * SZ_WFFI), NR - pm0 * 256, 2 * FF, D}; pg8::StaticOrder S; S.init(NR - pm0 * 256, 2 * FF, c.G, c.bx, D);
            EpiFfi E{HID, pm0}; pg8::gemm_phase<EpiFfi, pg8::StaticOrder, true, true>(c.lds, g, S, E, c.tid);
            if (rep_ == 0 && layer < 3) tail_convert(c, (NR / 256) * (2 * FF / 256), layer == 0 ? TAIL_FFI0_LO : (layer == 1 ? TAIL_FFI1_LO : TAIL_FFI2_LO), layer == 0 ? TAIL_FFI0_HI : (layer == 1 ? TAIL_FFI1_HI : TAIL_FFI2_HI)); } PH_END
        PH_BEGIN(12) { pg8::Gemm g{HID, (const bf16*)(c.ws + WS_WFFO + layer * SZ_WFFO), NR, D, FF}; ResCtxOrder S; S.init(c.G, c.bx, FF, layer < 3, 12, 4);
            EpiResSlab E{X, (bf16*)TA0, modl, 5}; pg8::gemm_phase<EpiResSlab, ResCtxOrder, true, true>(c.lds, g, S, E, c.tid); } PH_END
    }
    layer = 0;
    PH_BEGIN(13) phase_final(c, X, c.in[8], outp); PH_END
#undef PH_BEGIN
#undef PH_END
}

extern "C" void kernel_launch(void* const* d_in, const int* in_sizes, int n_in, void* d_out, int out_size, void* d_ws, size_t ws_size, hipStream_t stream) {
    static int grid = 0;
    if (grid == 0) {
        if (n_in != 24 || in_sizes[0] != NRL * D || out_size != NRL * D || ws_size < WS_END) { fprintf(stderr, "kernel_launch: unexpected shapes (n_in %d, in0 %d, out %d, ws %zu < %zu); nothing launched\n", n_in, n_in > 0 ? in_sizes[0] : -1, out_size, ws_size, (size_t)WS_END); grid = -1; return; }
        int dev = 0, cus = 0, per_cu = 0;
        if (hipGetDevice(&dev) != hipSuccess || hipDeviceGetAttribute(&cus, hipDeviceAttributeMultiprocessorCount, dev) != hipSuccess) { grid = -1; return; }
        if (hipFuncSetAttribute((const void*)mk_fwd, hipFuncAttributeMaxDynamicSharedMemorySize, LDS_BYTES) != hipSuccess) { fprintf(stderr, "kernel_launch: hipFuncSetAttribute failed\n"); grid = -1; return; }
        if (hipOccupancyMaxActiveBlocksPerMultiprocessor(&per_cu, (const void*)mk_fwd, NWAVES * 64, LDS_BYTES) != hipSuccess || per_cu < 1)
            fprintf(stderr, "kernel_launch: occupancy query reports %d workgroups per CU\n", per_cu);
        (void)hipGetLastError();
        grid = cus;
    }
    if (grid < 0) return;
    if (hipMemsetAsync((char*)d_ws + WS_CTL, 0, CTL_ZERO_BYTES, stream) != hipSuccess) return;
    Args a{};
    for (int i = 0; i < 24; ++i) a.in[i] = (const float*)d_in[i];
    a.out = (float*)d_out; a.ws = (unsigned char*)d_ws;
#if MK_ONE_LAUNCH
    a.ph_lo = 0; a.ph_hi = NPHASES;
    hipLaunchKernelGGL(mk_fwd, dim3(grid), dim3(NWAVES * 64), LDS_BYTES, stream, a);
#else
    for (int ph = 0; ph < NPHASES; ++ph) { a.ph_lo = ph; a.ph_hi = ph + 1; hipLaunchKernelGGL(mk_fwd, dim3(grid), dim3(NWAVES * 64), LDS_BYTES, stream, a); }
#endif
}
```

```cpp
#include <hip/hip_runtime.h>
#include <cstdio>
namespace pg8 {
#define PG8_LAS __attribute__((address_space(3)))
typedef unsigned short bf16_t;
typedef short bf16x8 __attribute__((ext_vector_type(8)));
typedef float f32x4 __attribute__((ext_vector_type(4)));
typedef unsigned u32x4 __attribute__((ext_vector_type(4)));
constexpr int BM = 256, BK = 64, HALF = 128, HTB = HALF * BK * 2  , STAGE_BYTES = 8 * HTB, NXCD = 8, WGM = 4;

__host__ __device__ __forceinline__ int lds_byte(int r, int c) { const int st = (r >> 4) * 2 + (c >> 5), rr = r & 15, cc = c & 31, ob = rr * 64 + cc * 2; return st * 1024 + (ob ^ (((ob >> 9) & 1) << 5)); }
__host__ __device__ __forceinline__ void stage_rc(int b, int& R, int& C) { const int st = b / 1024, sb = b % 1024, swz = sb ^ (((sb >> 9) & 1) << 5); R = (st >> 1) * 16 + swz / 64; C = (st & 1) * 32 + (swz % 64) / 2; }
__host__ __device__ __forceinline__ int perm32(int rho) { const int n = rho >> 4, i = rho & 15; return 8 * (i >> 2) + 4 * n + (i & 3); }

struct Unit { int pm, pn, k0, nt, ks; };
struct Gemm { const bf16_t* A; const bf16_t* Bt; int M, N, K; };

struct StaticOrder {
    int nM, nN, nwg, G, c, ntile;
    __host__ __device__ void init(int M, int N, int G_, int c_, int K_) { nM = M / BM; nN = N / BM; nwg = nM * nN; G = G_; c = c_; ntile = K_ / BK; }
    __host__ __device__ bool next(int i, Unit& u) const {
        const long L = (long)i * G + c; if (L >= nwg) return false;
        int wgid = (int)L; { const int q = nwg / NXCD, r = nwg % NXCD, xcd = wgid % NXCD, off = wgid / NXCD; wgid = (xcd < r ? xcd * (q + 1) : r * (q + 1) + (xcd - r) * q) + off; }
        const int nig = WGM * nN, gid = wgid / nig, fm = gid * WGM, gsz = (nM - fm) < WGM ? (nM - fm) : WGM;
        u.pm = fm + ((wgid % nig) % gsz); u.pn = (wgid % nig) / gsz; u.k0 = 0; u.nt = ntile; u.ks = 0; return true;
    }
    __device__ __forceinline__ void a_ready(const Unit&) const {}
    __device__ __forceinline__ void done(const Unit&) const {}
};

typedef __bf16 bf16v2_t __attribute__((ext_vector_type(2))); typedef float f32v2_t __attribute__((ext_vector_type(2)));
__device__ __forceinline__ unsigned cvt_pk_bf16(float lo, float hi) { const f32v2_t v = {lo, hi}; return __builtin_bit_cast(unsigned, __builtin_convertvector(v, bf16v2_t)); }
template <class Epi, class Sched, bool ALIGN_EPI = false, bool SP2 = false>
__device__ __forceinline__ void gemm_phase(PG8_LAS unsigned char* lds, const Gemm g, const Sched& S, const Epi& E, int tid_in) {
    int tid_l = tid_in; asm volatile("" : "+v"(tid_l));
    const int tid = tid_l, wid = __builtin_amdgcn_readfirstlane(tid >> 6), lane = tid & 63, wr = wid >> 2, wc = wid & 3, fr = lane & 15, fq = lane >> 4;
    const int K = g.K;
    unsigned voffA[2], voffB[2];
#pragma unroll
    for (int i = 0; i < 2; ++i) { int R, C; stage_rc(tid * 16 + i * 8192, R, C); const int Rb = Epi::PERM ? ((R & ~31) + perm32(R & 31)) : R;
        voffA[i] = (unsigned)(R * K + C) * 2u; voffB[i] = (unsigned)(Rb * K + C) * 2u; }
    const size_t kstep = (size_t)(BK * 2);
    const size_t hstep = (size_t)HALF * K * 2;
    const size_t tstep = 2 * hstep;
    const unsigned ldsw = (unsigned)wid * 1024u;
    const int aoff = lds_byte(wr * 64 + fr, fq * 8), boff = lds_byte(wc * 32 + fr, fq * 8);
#define PG8_SA(b, h) (((b) * 2 + (h)) * HTB)
#define PG8_SB(b, h) ((4 + (b) * 2 + (h)) * HTB)
#define PG8_STAGE(bufoff, gbase, voff) do { _Pragma("unroll") for (int _i = 0; _i < 2; ++_i) \
        __builtin_amdgcn_global_load_lds((const unsigned*)((const char*)(gbase) + (voff)[_i]), (PG8_LAS unsigned*)(lds + (bufoff) + ldsw + _i * 8192), 16, 0, 0); } while (0)
#define PG8_LDA(dst, b, h) do { _Pragma("unroll") for (int m = 0; m < 4; ++m) _Pragma("unroll") for (int k = 0; k < 2; ++k) dst[m][k] = *(const PG8_LAS bf16x8*)(lds + PG8_SA(b, h) + aoff + m * 2048 + k * 1024); } while (0)
#define PG8_LDB(dst, b, h) do { _Pragma("unroll") for (int n = 0; n < 2; ++n) _Pragma("unroll") for (int k = 0; k < 2; ++k) dst[n][k] = *(const PG8_LAS bf16x8*)(lds + PG8_SB(b, h) + boff + n * 2048 + k * 1024); } while (0)
#define PG8_MMA(ai, bj, At, Bt) do { __builtin_amdgcn_s_setprio(1); _Pragma("unroll") for (int m = 0; m < 4; ++m) _Pragma("unroll") for (int n = 0; n < 2; ++n) _Pragma("unroll") for (int k = 0; k < 2; ++k) \
        acc[ai][bj][m][n] = __builtin_amdgcn_mfma_f32_16x16x32_bf16(Bt[n][k], At[m][k], acc[ai][bj][m][n], 0, 0, 0); __builtin_amdgcn_s_setprio(0); } while (0)
#define PG8_WAIT_V(n) asm volatile("s_waitcnt vmcnt(" #n ")" ::: "memory")
#define PG8_WAIT_L(n) asm volatile("s_waitcnt lgkmcnt(" #n ")" ::: "memory")
#define PG8_WAIT_V8R(relax) asm volatile("s_cmp_eq_u32 %0, 0\n\ts_cbranch_scc1 1f\n\ts_waitcnt vmcnt(%1)\n\ts_branch 2f\n1:\n\ts_waitcnt vmcnt(8)\n2:" :: "s"(relax), "i"(8 + Epi::NOPS) : "memory", "scc")
#define PG8_BAR __builtin_amdgcn_s_barrier()
#define PG8_SCHED __builtin_amdgcn_sched_barrier(0)
    Unit cur, nxt; int ui = 0;
    if (!S.next(0, cur)) return;
    f32x4 acc[2][2][4][2];
#pragma unroll
    for (int a = 0; a < 2; ++a)
#pragma unroll
        for (int b = 0; b < 2; ++b)
#pragma unroll
            for (int m = 0; m < 4; ++m)
#pragma unroll
                for (int n = 0; n < 2; ++n) acc[a][b][m][n] = (f32x4){0.f, 0.f, 0.f, 0.f};
    bf16x8 At[4][2], B0[2][2], B1[2][2];
    const char* cA = (const char*)g.A + (size_t)cur.pm * tstep + (size_t)cur.k0 * 2; const char* cB = (const char*)g.Bt + (size_t)cur.pn * tstep + (size_t)cur.k0 * 2;
    S.a_ready(cur);
    if constexpr (SP2) {
        PG8_STAGE(PG8_SB(0, 0), cB, voffB); PG8_STAGE(PG8_SB(0, 1), cB + hstep, voffB); PG8_STAGE(PG8_SA(0, 0), cA, voffA); PG8_STAGE(PG8_SA(0, 1), cA + hstep, voffA);
        if (wr == 1) PG8_BAR;
        PG8_WAIT_V(2); PG8_BAR;
        PG8_STAGE(PG8_SB(1, 0), cB + kstep, voffB); PG8_STAGE(PG8_SA(1, 0), cA + kstep, voffA); PG8_STAGE(PG8_SB(1, 1), cB + hstep + kstep, voffB);
        PG8_WAIT_V(6); PG8_BAR;
    } else {
        PG8_STAGE(PG8_SB(0, 0), cB, voffB); PG8_STAGE(PG8_SA(0, 0), cA, voffA); PG8_STAGE(PG8_SB(0, 1), cB + hstep, voffB); PG8_STAGE(PG8_SA(0, 1), cA + hstep, voffA);
        if (wr == 1) PG8_BAR;
        PG8_WAIT_V(4); PG8_BAR;
        PG8_STAGE(PG8_SB(1, 0), cB + kstep, voffB); PG8_STAGE(PG8_SA(1, 0), cA + kstep, voffA); PG8_STAGE(PG8_SB(1, 1), cB + hstep + kstep, voffB);
        PG8_WAIT_V(6); PG8_BAR;
    }
    for (;;) {
        const bool has_next = S.next(ui + 1, nxt);
        const char* nA = has_next ? (const char*)g.A + (size_t)nxt.pm * tstep + (size_t)nxt.k0 * 2 : cA; const char* nB = has_next ? (const char*)g.Bt + (size_t)nxt.pn * tstep + (size_t)nxt.k0 * 2 : cB;
        const int nt = cur.nt;
        for (int t = 0; t < nt; t += 2) {
            const bool last = (t == nt - 2);
            const char* a1 = cA + (size_t)(t + 1) * kstep;
            const char* a2 = last ? nA : cA + (size_t)(t + 2) * kstep; const char* b2 = last ? nB : cB + (size_t)(t + 2) * kstep;
            const char* a3 = a2 + kstep; const char* b3 = b2 + kstep;
            if (last && has_next) S.a_ready(nxt);
            if constexpr (SP2) {
            PG8_LDB(B0, 0, 0); PG8_LDB(B1, 0, 1); PG8_SCHED; PG8_LDA(At, 0, 0); PG8_STAGE(PG8_SA(1, 1), a1 + hstep, voffA);
            PG8_WAIT_V(8); PG8_WAIT_L(0); PG8_BAR; PG8_MMA(0, 0, At, B0); PG8_MMA(0, 1, At, B1); PG8_BAR; PG8_SCHED;
            PG8_LDA(At, 0, 1); PG8_STAGE(PG8_SB(0, 0), b2, voffB); PG8_STAGE(PG8_SB(0, 1), b2 + hstep, voffB); PG8_STAGE(PG8_SA(0, 0), a2, voffA);
            PG8_WAIT_V(8); PG8_WAIT_L(0); PG8_BAR; PG8_MMA(1, 0, At, B0); PG8_MMA(1, 1, At, B1); PG8_BAR; PG8_SCHED;
            PG8_LDB(B0, 1, 0); PG8_LDB(B1, 1, 1); PG8_SCHED; PG8_LDA(At, 1, 0); PG8_STAGE(PG8_SA(0, 1), a2 + hstep, voffA);
            PG8_WAIT_V(8); PG8_WAIT_L(0); PG8_BAR; PG8_MMA(0, 0, At, B0); PG8_MMA(0, 1, At, B1); PG8_BAR; PG8_SCHED;
            PG8_LDA(At, 1, 1); PG8_STAGE(PG8_SB(1, 0), b3, voffB); PG8_STAGE(PG8_SB(1, 1), b3 + hstep, voffB); PG8_STAGE(PG8_SA(1, 0), a3, voffA);
            PG8_WAIT_V(8); PG8_WAIT_L(0); PG8_BAR; PG8_MMA(1, 0, At, B0); PG8_MMA(1, 1, At, B1); PG8_BAR; PG8_SCHED;
            } else {
            PG8_LDB(B0, 0, 0); PG8_SCHED; PG8_LDA(At, 0, 0); PG8_STAGE(PG8_SA(1, 1), a1 + hstep, voffA);
            PG8_WAIT_L(8); PG8_BAR; PG8_WAIT_L(0); PG8_MMA(0, 0, At, B0); PG8_BAR; PG8_SCHED;
            PG8_LDB(B1, 0, 1); PG8_STAGE(PG8_SB(0, 0), b2, voffB);
            PG8_BAR; PG8_WAIT_L(0); PG8_MMA(0, 1, At, B1); PG8_BAR;
            PG8_LDA(At, 0, 1); PG8_STAGE(PG8_SA(0, 0), a2, voffA);
            PG8_BAR; PG8_WAIT_L(0); PG8_MMA(1, 0, At, B0); PG8_BAR; PG8_SCHED;
            PG8_STAGE(PG8_SB(0, 1), b2 + hstep, voffB);
            PG8_WAIT_V(6); PG8_BAR; PG8_MMA(1, 1, At, B1); PG8_BAR;
            PG8_LDB(B0, 1, 0); PG8_SCHED; PG8_LDA(At, 1, 0); PG8_STAGE(PG8_SA(0, 1), a2 + hstep, voffA);
            PG8_WAIT_L(8); PG8_BAR; PG8_WAIT_L(0); PG8_MMA(0, 0, At, B0); PG8_BAR; PG8_SCHED;
            PG8_LDB(B1, 1, 1); PG8_STAGE(PG8_SB(1, 0), b3, voffB);
            PG8_BAR; PG8_WAIT_L(0); PG8_MMA(0, 1, At, B1); PG8_BAR;
            PG8_LDA(At, 1, 1); PG8_STAGE(PG8_SA(1, 0), a3, voffA);
            PG8_BAR; PG8_WAIT_L(0); PG8_MMA(1, 0, At, B0); PG8_BAR; PG8_SCHED;
            PG8_STAGE(PG8_SB(1, 1), b3 + hstep, voffB);
            PG8_WAIT_V(6); PG8_BAR; PG8_MMA(1, 1, At, B1); PG8_BAR;
            }
        }
        if constexpr (ALIGN_EPI) { if (wr == 0) PG8_BAR; }
        if constexpr (!Epi::AFTER_DRAIN) { E(acc, cur, wr, wc, fr, fq);
#if defined(PROBE_EPI2)
            if constexpr (Epi::PERM) { asm volatile("" ::: "memory"); E(acc, cur, wr, wc, fr, fq); }
#endif
            S.done(cur); }
        if (!has_next) break;
#pragma unroll
        for (int a = 0; a < 2; ++a)
#pragma unroll
            for (int b = 0; b < 2; ++b)
#pragma unroll
                for (int m = 0; m < 4; ++m)
#pragma unroll
                    for (int n = 0; n < 2; ++n) acc[a][b][m][n] = (f32x4){0.f, 0.f, 0.f, 0.f};
        cur = nxt; cA = nA; cB = nB; ++ui;
        if constexpr (ALIGN_EPI) { if (wr == 1) PG8_BAR; }
    }
    PG8_WAIT_V(0);
    if constexpr (!ALIGN_EPI) { if (wr == 0) PG8_BAR; }
    PG8_BAR;
    if constexpr (Epi::AFTER_DRAIN) { E.fused(acc, cur, wr, wc, fr, fq, lds, wid, lane); S.done(cur); }
#undef PG8_SA
#undef PG8_SB
#undef PG8_STAGE
#undef PG8_LDA
#undef PG8_LDB
#undef PG8_MMA
#undef PG8_WAIT_V
#undef PG8_WAIT_L
#undef PG8_WAIT_V8R
#undef PG8_BAR
#undef PG8_SCHED
}
}

#ifndef MK_ONE_LAUNCH
#define MK_ONE_LAUNCH 1
#endif
constexpr int D = 2048, NBATCH = 4, SEQ = 4096, CTXL = 256, DEPTH = 4;
constexpr int NRC = NBATCH * CTXL, NRL = NBATCH * SEQ, NR = NRC + NRL;
constexpr int FF = 5632, MLIN = 6176, MLINP = 6400;
constexpr int NHEAD = 8, DV = 256, DQK = 128;
constexpr float EPSN = 1e-6f;
constexpr int NWAVES = 8;

constexpr size_t MiB = 1u << 20;
constexpr size_t WS_CTL = 0, CTL_ZERO_BYTES = 1 * MiB;
constexpr size_t WS_MOD = 1 * MiB;
constexpr size_t WS_WFFI = 2 * MiB,   SZ_WFFI = (size_t)2 * FF * D * 2;
constexpr size_t WS_WFFO = 178 * MiB, SZ_WFFO = (size_t)D * FF * 2;
constexpr size_t WS_WGLU = 266 * MiB, SZ_WGLU = (size_t)2 * D * D * 2;
constexpr size_t WS_WMLI = 298 * MiB, SZ_WMLI = (size_t)MLINP * D * 2;
constexpr size_t WS_WMLO = 348 * MiB, SZ_WMLO = (size_t)D * D * 2;
constexpr size_t WS_X = 364 * MiB;
constexpr size_t WS_U = 500 * MiB;
constexpr size_t WS_G = 568 * MiB;
constexpr size_t WS_HID = 636 * MiB;
constexpr size_t WS_TA = 823 * MiB, SZ_F32ROWS = (size_t)NR * D * 4;
constexpr size_t WS_Q = 1095 * MiB, WS_K = 1129 * MiB, WS_V = 1163 * MiB, WS_O = 1231 * MiB, WS_GATES = 1299 * MiB;
constexpr size_t WS_END = 1302 * MiB;
static_assert(WS_WFFI + 4 * SZ_WFFI <= WS_WFFO && WS_WFFO + 4 * SZ_WFFO <= WS_WGLU && WS_WGLU + 2 * SZ_WGLU <= WS_WMLI && WS_WMLI + 2 * SZ_WMLI <= WS_WMLO && WS_WMLO + 2 * SZ_WMLO <= WS_X, "ws map 1");
static_assert(WS_X + SZ_F32ROWS <= WS_U && WS_U + (size_t)NR * D * 2 <= WS_G && WS_G + (size_t)NR * D * 2 <= WS_HID && WS_HID + (size_t)NR * FF * 2 <= WS_TA && WS_TA + 2 * SZ_F32ROWS <= WS_Q, "ws map 2");
static_assert(WS_Q + (size_t)NR * 1024 * 2 <= WS_K && WS_K + (size_t)NR * 1024 * 2 <= WS_V && WS_V + (size_t)NR * D * 2 <= WS_O && WS_O + (size_t)NR * D * 2 <= WS_GATES && WS_GATES + (size_t)NR * 32 * 4 <= WS_END, "ws map 3");
constexpr int CW_BAR = 4096;

constexpr int RING_BYTES = 131072, LDSCTL_OFF = RING_BYTES, MISC_OFF = LDSCTL_OFF + 320, LDS_BYTES = 147456;

#define GAS __attribute__((address_space(1)))
#define LAS __attribute__((address_space(3)))
typedef unsigned short bf16;
typedef unsigned v4u __attribute__((ext_vector_type(4)));
typedef unsigned v2u __attribute__((ext_vector_type(2)));
typedef float f32x4 __attribute__((ext_vector_type(4)));
typedef short bf16x8 __attribute__((ext_vector_type(8)));

__device__ __forceinline__ unsigned f2bf(float f) { unsigned u = __builtin_bit_cast(unsigned, f); return (u + 0x7fffu + ((u >> 16) & 1u)) >> 16; }
__device__ __forceinline__ unsigned pk2(float lo, float hi) { return pg8::cvt_pk_bf16(lo, hi); }
__device__ __forceinline__ float bflo(unsigned w) { return __builtin_bit_cast(float, w << 16); }
__device__ __forceinline__ float bfhi(unsigned w) { return __builtin_bit_cast(float, w & 0xffff0000u); }
__device__ __forceinline__ float bf2f(bf16 b) { return __builtin_bit_cast(float, ((unsigned)b) << 16); }
__device__ __forceinline__ float fsigmoid(float x) { return __builtin_amdgcn_rcpf(1.0f + __builtin_amdgcn_exp2f(-1.4426950408889634f * x)); }
__device__ __forceinline__ float wave_sum(float v) {
#pragma unroll
    for (int o = 1; o < 64; o <<= 1) v += __shfl_xor(v, o);
    return v;
}

#define XB_TMO      128
#define XB_XCNT(j)  (256  + 64 * (j))
#define XB_XSUB(j)  (1280 + 64 * (j))
#define XB_XGEN(j)  (2304 + 64 * (j))
#define XB_TOP      3328
#define XB_TOPGEN   3392
#define XCD_BAR_WORDS 3456
#define XB_SPIN_CAP (1u << 18)
__device__ __forceinline__ unsigned xb_ld(unsigned* p)              { return __hip_atomic_load(p, __ATOMIC_RELAXED, __HIP_MEMORY_SCOPE_AGENT); }
__device__ __forceinline__ unsigned xb_add(unsigned* p, unsigned v) { return __hip_atomic_fetch_add(p, v, __ATOMIC_RELAXED, __HIP_MEMORY_SCOPE_AGENT); }
__device__ __forceinline__ unsigned xb_xcc_id() { return (unsigned)__builtin_amdgcn_s_getreg((3 << 11) | 20) & 0xFu; }
#define XB_SPIN(cond, bar) do { unsigned _sp = 0; while (cond) { __builtin_amdgcn_s_sleep(1); \
    if ((++_sp & 255u) == 0u) { if (xb_ld(&(bar)[XB_TMO])) break; if (_sp > XB_SPIN_CAP) { atomicAdd(&(bar)[XB_TMO], 1u); break; } } } } while (0)
__device__ __forceinline__ int mk_lane() { unsigned m = ~0u; asm volatile("" : "+s"(m)); return (int)__builtin_amdgcn_mbcnt_hi(m, __builtin_amdgcn_mbcnt_lo(m, 0u)); }
struct XcdBarrier { unsigned* bar; unsigned x; volatile LAS unsigned* st; };
__device__ __forceinline__ XcdBarrier xcd_barrier_post(unsigned* bar, volatile LAS unsigned* st, int wave) {
    XcdBarrier b; b.bar = bar; b.x = xb_xcc_id(); b.st = st;
    if (wave == 0 && mk_lane() == 0) (void)xb_add(&bar[XB_XCNT(b.x)], 1u);
    return b;
}
__device__ __forceinline__ void xcd_barrier_complete(unsigned* bar, unsigned x, unsigned& nloc, unsigned& nx) {
    const unsigned G = gridDim.x * gridDim.y * gridDim.z;
    unsigned sum, cnt, mine, sp = 0u;
    for (;;) {
        sum = 0u; cnt = 0u; mine = 0u;
#pragma unroll
        for (unsigned j = 0; j < 16; ++j) { const unsigned c = xb_ld(&bar[XB_XCNT(j)]); sum += c; cnt += (c > 0u) ? 1u : 0u; mine = (j == x) ? c : mine; }
        if (sum == G) break;
        __builtin_amdgcn_s_sleep(1);
        if ((++sp & 255u) == 0u) { if (xb_ld(&bar[XB_TMO])) break; if (sp > XB_SPIN_CAP) { atomicAdd(&bar[XB_TMO], 1u); break; } }
    }
    nloc = mine > 0u ? mine : 1u; nx = cnt > 0u ? cnt : 1u;
}
__device__ __forceinline__ void xcd_barrier(const XcdBarrier& b, int wave) {
    asm volatile("s_waitcnt vmcnt(0)" ::: "memory");
    __syncthreads();
    if (wave == 0 && mk_lane() == 0) {
        unsigned* bar = b.bar;
        __builtin_amdgcn_s_waitcnt(0);
        unsigned nloc = b.st[0], nx = b.st[1];
        if (nloc == 0u) { xcd_barrier_complete(bar, b.x, nloc, nx); b.st[0] = nloc; b.st[1] = nx; }
        const unsigned old = xb_add(&bar[XB_XSUB(b.x)], 1u);
        const unsigned gen = old / nloc;
        if (old + 1u == (gen + 1u) * nloc) {
            __builtin_amdgcn_fence(__ATOMIC_RELEASE, "agent");
            asm volatile("s_waitcnt vmcnt(0)" ::: "memory");
            const unsigned og = xb_add(&bar[XB_TOP], 1u);
            const unsigned tg = og / nx;
            if (og + 1u == (tg + 1u) * nx) xb_add(&bar[XB_TOPGEN], 1u);
            else XB_SPIN(xb_ld(&bar[XB_TOPGEN]) == tg, bar);
            __builtin_amdgcn_fence(__ATOMIC_ACQUIRE, "agent");
            xb_add(&bar[XB_XGEN(b.x)], 1u);
            asm volatile("s_waitcnt vmcnt(0)" ::: "memory");
        } else {
            XB_SPIN(xb_ld(&bar[XB_XGEN(b.x)]) == gen, bar);
            __builtin_amdgcn_fence(__ATOMIC_ACQUIRE, "agent");
            asm volatile("s_waitcnt vmcnt(0)" ::: "memory");
        }
    }
    __syncthreads();
}

__device__ __forceinline__ int row_r(int pm) { return pm < 4 ? 4 : ((pm - 4) >> 4); }

struct EpiGlu {
    static constexpr bool PERM = true, AFTER_DRAIN = false;
    static constexpr int NOPS = 18;
    const float* b32ctx; const float* b32lat; bf16* X; const float* mod; int pm0; int src32;
    __device__ __forceinline__ void operator()(const pg8::f32x4 (&acc)[2][2][4][2], const pg8::Unit& u, int wr, int wc, int fr, int fq) const {
        const int pmg = u.pm + pm0; const int r = row_r(pmg); const int j0 = u.pn * 128 + wc * 32 + 8 * fq;
        const float* gp = mod + (size_t)(r * 6 + 2) * D + j0;
        const f32x4 g0 = *(const f32x4*)gp, g1 = *(const f32x4*)(gp + 4);
        if (src32) {
            f32x4 bs[2][4][2];
#pragma unroll
            for (int ai = 0; ai < 2; ++ai)
#pragma unroll
                for (int m = 0; m < 4; ++m) {
                    const int R = pmg * 256 + ai * 128 + wr * 64 + m * 16 + fr;
                    const float* bp = (R < NRC ? b32ctx + (size_t)R * D : b32lat + (size_t)(R - NRC) * D) + j0;
#pragma unroll
                    for (int n = 0; n < 2; ++n) bs[ai][m][n] = __builtin_nontemporal_load((const f32x4*)(bp + 4 * n)); }
            asm volatile("" ::: "memory");
#pragma unroll
            for (int ai = 0; ai < 2; ++ai)
#pragma unroll
                for (int m = 0; m < 4; ++m) {
                    const int R = pmg * 256 + ai * 128 + wr * 64 + m * 16 + fr;
                    float o[8];
#pragma unroll
                    for (int n = 0; n < 2; ++n) {
                        const f32x4 a = acc[ai][0][m][n], b = acc[ai][1][m][n]; const f32x4 gv = n ? g1 : g0;
#pragma unroll
                        for (int e = 0; e < 4; ++e) o[4 * n + e] = bs[ai][m][n][e] + gv[e] * (a[e] * __builtin_amdgcn_rcpf(1.0f + __builtin_amdgcn_exp2f(b[e]))); }
                    v4u w; w.x = pg8::cvt_pk_bf16(o[0], o[1]); w.y = pg8::cvt_pk_bf16(o[2], o[3]); w.z = pg8::cvt_pk_bf16(o[4], o[5]); w.w = pg8::cvt_pk_bf16(o[6], o[7]);
                    *(v4u*)(X + (size_t)R * D + j0) = w; }
        } else {
            v4u bs[2][4];
#pragma unroll
            for (int ai = 0; ai < 2; ++ai)
#pragma unroll
                for (int m = 0; m < 4; ++m) { const int R = pmg * 256 + ai * 128 + wr * 64 + m * 16 + fr; bs[ai][m] = *(const v4u*)(X + (size_t)R * D + j0); }
            asm volatile("" ::: "memory");
#pragma unroll
            for (int ai = 0; ai < 2; ++ai)
#pragma unroll
                for (int m = 0; m < 4; ++m) {
                    const int R = pmg * 256 + ai * 128 + wr * 64 + m * 16 + fr;
                    const v4u bw = bs[ai][m]; const float bv[8] = {bflo(bw.x), bfhi(bw.x), bflo(bw.y), bfhi(bw.y), bflo(bw.z), bfhi(bw.z), bflo(bw.w), bfhi(bw.w)};
                    float o[8];
#pragma unroll
                    for (int n = 0; n < 2; ++n) {
                        const f32x4 a = acc[ai][0][m][n], b = acc[ai][1][m][n]; const f32x4 gv = n ? g1 : g0;
#pragma unroll
                        for (int e = 0; e < 4; ++e) o[4 * n + e] = bv[4 * n + e] + gv[e] * (a[e] * __builtin_amdgcn_rcpf(1.0f + __builtin_amdgcn_exp2f(b[e]))); }
                    v4u w; w.x = pg8::cvt_pk_bf16(o[0], o[1]); w.y = pg8::cvt_pk_bf16(o[2], o[3]); w.z = pg8::cvt_pk_bf16(o[4], o[5]); w.w = pg8::cvt_pk_bf16(o[6], o[7]);
                    *(v4u*)(X + (size_t)R * D + j0) = w; }
        }
    }
};
struct EpiFfi {
    static constexpr bool PERM = true, AFTER_DRAIN = false;
    bf16* H; int pm0;
    static constexpr int NOPS = 8;
    __device__ __forceinline__ void operator()(const pg8::f32x4 (&acc)[2][2][4][2], const pg8::Unit& u, int wr, int wc, int fr, int fq) const {
        const int j0 = u.pn * 128 + wc * 32 + 8 * fq;
#pragma unroll
        for (int ai = 0; ai < 2; ++ai)
#pragma unroll
            for (int m = 0; m < 4; ++m) {
                const int R = (u.pm + pm0) * 256 + ai * 128 + wr * 64 + m * 16 + fr;
                float h[8];
#pragma unroll
                for (int n = 0; n < 2; ++n)
#pragma unroll
                    for (int e = 0; e < 4; ++e) { const float g = acc[ai][0][m][n][e], up = acc[ai][1][m][n][e]; h[4 * n + e] = (g * up) * __builtin_amdgcn_rcpf(1.0f + __builtin_amdgcn_exp2f(-g)); }
                v4u w; w.x = pg8::cvt_pk_bf16(h[0], h[1]); w.y = pg8::cvt_pk_bf16(h[2], h[3]); w.z = pg8::cvt_pk_bf16(h[4], h[5]); w.w = pg8::cvt_pk_bf16(h[6], h[7]);
                *(v4u*)(H + (size_t)R * FF + j0) = w; }
    }
};
template <bool MLPERM> struct EpiRes {
    static constexpr bool PERM = true, AFTER_DRAIN = false;
    bf16* X; const float* mod; int gidx; int pm0;
    static constexpr int NOPS = 16;
    __device__ __forceinline__ void operator()(const pg8::f32x4 (&acc)[2][2][4][2], const pg8::Unit& u, int wr, int wc, int fr, int fq) const {
        const int pmg = u.pm + pm0; const int r = row_r(pmg); const int c0 = u.pn * 256 + wc * 32 + 8 * fq;
        const float* gp = mod + (size_t)(r * 6 + gidx) * D + c0;
        f32x4 gv[2][2];
#pragma unroll
        for (int bj = 0; bj < 2; ++bj)
#pragma unroll
            for (int n = 0; n < 2; ++n) gv[bj][n] = *(const f32x4*)(gp + bj * 128 + n * 4);
        v4u bs[2][4][2];
#pragma unroll
        for (int ai = 0; ai < 2; ++ai)
#pragma unroll
            for (int m = 0; m < 4; ++m) {
                int R = pmg * 256 + ai * 128 + wr * 64 + m * 16 + fr;
                if (MLPERM && R >= NRC) { const int q = R - NRC, p = q & 4095; R = NRC + (q & ~4095) + ((p & 63) << 6) + (p >> 6); }
                const bf16* xp = X + (size_t)R * D + c0;
#pragma unroll
                for (int bj = 0; bj < 2; ++bj) bs[ai][m][bj] = *(const v4u*)(xp + bj * 128); }
        asm volatile("" ::: "memory");
#pragma unroll
        for (int ai = 0; ai < 2; ++ai)
#pragma unroll
            for (int m = 0; m < 4; ++m) {
                int R = pmg * 256 + ai * 128 + wr * 64 + m * 16 + fr;
                if (MLPERM && R >= NRC) { const int q = R - NRC, p = q & 4095; R = NRC + (q & ~4095) + ((p & 63) << 6) + (p >> 6); }
                bf16* xp = X + (size_t)R * D + c0;
#pragma unroll
                for (int bj = 0; bj < 2; ++bj) {
                    const v4u bw = bs[ai][m][bj]; const f32x4 a0 = acc[ai][bj][m][0], a1 = acc[ai][bj][m][1], ga = gv[bj][0], gb = gv[bj][1];
                    v4u w; w.x = pg8::cvt_pk_bf16(bflo(bw.x) + ga[0] * a0[0], bfhi(bw.x) + ga[1] * a0[1]); w.y = pg8::cvt_pk_bf16(bflo(bw.y) + ga[2] * a0[2], bfhi(bw.y) + ga[3] * a0[3]);
                    w.z = pg8::cvt_pk_bf16(bflo(bw.z) + gb[0] * a1[0], bfhi(bw.z) + gb[1] * a1[1]); w.w = pg8::cvt_pk_bf16(bflo(bw.w) + gb[2] * a1[2], bfhi(bw.w) + gb[3] * a1[3]);
                    *(v4u*)(xp + bj * 128) = w; } }
    }
};
struct EpiSlab {
    static constexpr bool PERM = true, AFTER_DRAIN = false;
    bf16* slab; const float* mod; int gidx;
    static constexpr int NOPS = 12;
    __device__ __forceinline__ void operator()(const pg8::f32x4 (&acc)[2][2][4][2], const pg8::Unit& u, int wr, int wc, int fr, int fq) const {
        const int c0 = u.pn * 256 + wc * 32 + 8 * fq;
        const float* gp = mod + (size_t)(4 * 6 + gidx) * D + c0;
        f32x4 gv[2][2];
#pragma unroll
        for (int bj = 0; bj < 2; ++bj)
#pragma unroll
            for (int n = 0; n < 2; ++n) gv[bj][n] = *(const f32x4*)(gp + bj * 128 + n * 4);
        bf16* sp = slab + (size_t)u.ks * NRC * D;
#pragma unroll
        for (int ai = 0; ai < 2; ++ai)
#pragma unroll
            for (int m = 0; m < 4; ++m) {
                const int R = u.pm * 256 + ai * 128 + wr * 64 + m * 16 + fr;
                bf16* xp = sp + (size_t)R * D + c0;
#pragma unroll
                for (int bj = 0; bj < 2; ++bj) { const f32x4 p0 = gv[bj][0] * acc[ai][bj][m][0], p1 = gv[bj][1] * acc[ai][bj][m][1];
                    v4u w; w.x = pg8::cvt_pk_bf16(p0[0], p0[1]); w.y = pg8::cvt_pk_bf16(p0[2], p0[3]); w.z = pg8::cvt_pk_bf16(p1[0], p1[1]); w.w = pg8::cvt_pk_bf16(p1[2], p1[3]);
                    *(v4u*)(xp + bj * 128) = w; } }
    }
};
struct CtxSplitOrder {
    int G, c, npn, t_hi, n_hi;
    __device__ __forceinline__ bool next(int i, pg8::Unit& u) const {
        const int L = i * G + c; if (L >= 32 * npn) return false;
        const int ks = L & 7, rest = L >> 3; u.pn = rest % npn; u.pm = rest / npn; u.ks = ks;
        u.nt = ks < n_hi ? t_hi : t_hi - 2; u.k0 = 64 * (ks < n_hi ? ks * t_hi : n_hi * t_hi + (ks - n_hi) * (t_hi - 2)); return true;
    }
    __device__ __forceinline__ void a_ready(const pg8::Unit&) const {}
    __device__ __forceinline__ void done(const pg8::Unit&) const {}
};
struct ResCtxOrder {
    int G, c, t_full, t_hi, n_hi; bool with_ctx;
    __device__ __forceinline__ void init(int G_, int c_, int K, bool wc, int t_hi_, int n_hi_) { G = G_; c = c_; t_full = K / 64; t_hi = t_hi_; n_hi = n_hi_; with_ctx = wc; }
    __device__ __forceinline__ bool next(int i, pg8::Unit& u) const {
        constexpr int NLAT = (NRL / 256) * (D / 256);
        const int L = i * G + c;
        int pm, pn, k0, nt, ks; bool ok = true;
        if (L < NLAT) {
            int wgid = L; { const int q = NLAT / pg8::NXCD, xcd = wgid % pg8::NXCD, off = wgid / pg8::NXCD; wgid = xcd * q + off; }
            const int nig = pg8::WGM * (D / 256), gid = wgid / nig, fm = gid * pg8::WGM;
            pm = 4 + fm + ((wgid % nig) % pg8::WGM); pn = (wgid % nig) / pg8::WGM; k0 = 0; nt = t_full; ks = -1;
        } else {
            const int Lc = L - ((NLAT + G - 1) / G) * G;
            ok = with_ctx && Lc >= 0 && Lc < 32 * 8;
            ks = Lc & 7; const int rest = Lc >> 3; pn = rest & 7; pm = (rest >> 3) & 3;
            nt = ks < n_hi ? t_hi : t_hi - 2; k0 = 64 * (ks < n_hi ? ks * t_hi : n_hi * t_hi + (ks - n_hi) * (t_hi - 2));
        }
        u.pm = pm; u.pn = pn; u.k0 = k0; u.nt = nt; u.ks = ks; return ok;
    }
    __device__ __forceinline__ void a_ready(const pg8::Unit&) const {}
    __device__ __forceinline__ void done(const pg8::Unit&) const {}
};
struct EpiResSlab {
    static constexpr bool PERM = true, AFTER_DRAIN = false;
    static constexpr int NOPS = 12;
    bf16* X; bf16* slab; const float* mod; int gidx;
    __device__ __forceinline__ void operator()(const pg8::f32x4 (&acc)[2][2][4][2], const pg8::Unit& u, int wr, int wc, int fr, int fq) const {
        const bool lat = u.ks < 0;
        const int r = row_r(u.pm); const int c0 = u.pn * 256 + wc * 32 + 8 * fq;
        const float* gp = mod + (size_t)(r * 6 + gidx) * D + c0;
        f32x4 gv[2][2];
#pragma unroll
        for (int bj = 0; bj < 2; ++bj)
#pragma unroll
            for (int n = 0; n < 2; ++n) gv[bj][n] = *(const f32x4*)(gp + bj * 128 + n * 4);
        bf16* dst = (lat ? X : slab + (size_t)u.ks * NRC * D) + (size_t)(u.pm * 256 + wr * 64 + fr) * D + c0;
        v4u bs[2][4][2];
#pragma unroll
        for (int ai = 0; ai < 2; ++ai)
#pragma unroll
            for (int m = 0; m < 4; ++m)
#pragma unroll
                for (int bj = 0; bj < 2; ++bj) bs[ai][m][bj] = (v4u){0u, 0u, 0u, 0u};
        if (lat) {
#pragma unroll
            for (int ai = 0; ai < 2; ++ai)
#pragma unroll
                for (int m = 0; m < 4; ++m)
#pragma unroll
                    for (int bj = 0; bj < 2; ++bj) bs[ai][m][bj] = *(const v4u*)(dst + (size_t)(ai * 128 + m * 16) * D + bj * 128); }
        asm volatile("" ::: "memory");
#pragma unroll
        for (int ai = 0; ai < 2; ++ai)
#pragma unroll
            for (int m = 0; m < 4; ++m)
#pragma unroll
                for (int bj = 0; bj < 2; ++bj) {
                    const v4u bw = bs[ai][m][bj]; const f32x4 a0 = acc[ai][bj][m][0], a1 = acc[ai][bj][m][1], ga = gv[bj][0], gb = gv[bj][1];
                    v4u w; w.x = pg8::cvt_pk_bf16(bflo(bw.x) + ga[0] * a0[0], bfhi(bw.x) + ga[1] * a0[1]); w.y = pg8::cvt_pk_bf16(bflo(bw.y) + ga[2] * a0[2], bfhi(bw.y) + ga[3] * a0[3]);
                    w.z = pg8::cvt_pk_bf16(bflo(bw.z) + gb[0] * a1[0], bfhi(bw.z) + gb[1] * a1[1]); w.w = pg8::cvt_pk_bf16(bflo(bw.w) + gb[2] * a1[2], bfhi(bw.w) + gb[3] * a1[3]);
                    *(v4u*)(dst + (size_t)(ai * 128 + m * 16) * D + bj * 128) = w; }
    }
};
struct EpiMli {
    static constexpr bool PERM = true, AFTER_DRAIN = false;
    bf16 *Q, *K, *V, *O; float* GATES; const float* bg;
    static constexpr int NOPS = 0;
    __device__ __forceinline__ void operator()(const pg8::f32x4 (&acc)[2][2][4][2], const pg8::Unit& u, int wr, int wc, int fr, int fq) const {
        const int pn = u.pn;
        if (pn < 24) {
            bf16* base; int ldc, colt; float sc = 1.f;
            if (pn < 4) { base = Q; ldc = 1024; colt = pn * 256; sc = 0.08838834764831845f; } else if (pn < 8) { base = K; ldc = 1024; colt = (pn - 4) * 256; }
            else if (pn < 16) { base = V; ldc = D; colt = (pn - 8) * 256; } else { base = O; ldc = D; colt = (pn - 16) * 256; }
            const int col0 = colt + wc * 32 + 8 * fq;
#pragma unroll
            for (int ai = 0; ai < 2; ++ai)
#pragma unroll
                for (int m = 0; m < 4; ++m) {
                    const int R = u.pm * 256 + ai * 128 + wr * 64 + m * 16 + fr; bf16* rowp = base + (size_t)R * ldc + col0;
#pragma unroll
                    for (int bj = 0; bj < 2; ++bj) { const f32x4 v0 = acc[ai][bj][m][0] * sc, v1 = acc[ai][bj][m][1] * sc; v4u w;
                        w.x = pg8::cvt_pk_bf16(v0[0], v0[1]); w.y = pg8::cvt_pk_bf16(v0[2], v0[3]); w.z = pg8::cvt_pk_bf16(v1[0], v1[1]); w.w = pg8::cvt_pk_bf16(v1[2], v1[3]);
                        if (pn >= 16) __builtin_nontemporal_store(w, (v4u*)(rowp + bj * 128)); else *(v4u*)(rowp + bj * 128) = w; } }
        } else if (wc == 0) {
#pragma unroll
            for (int ai = 0; ai < 2; ++ai)
#pragma unroll
                for (int m = 0; m < 4; ++m) {
                    const int R = u.pm * 256 + ai * 128 + wr * 64 + m * 16 + fr;
#pragma unroll
                    for (int n = 0; n < 2; ++n) { const int gc = 8 * fq + 4 * n; const f32x4 bv = *(const f32x4*)(bg + gc); f32x4 o;
#pragma unroll
                        for (int e = 0; e < 4; ++e) { const float z = (acc[ai][0][m][n][e] + bv[e]) * (1.0f / 15.0f); float gcap = 15.0f * tanhf(z);
                            if (fq & 1) gcap = fminf(gcap, 0.f) - log1pf(expf(-fabsf(gcap)));
                            o[e] = gcap; }
                        *(f32x4*)(GATES + (size_t)R * 32 + gc) = o; } }
        }
    }
};

__device__ __forceinline__ void transpose_item(const float* W, int K, int N, bf16* WT, int kb, int n0, int drow0, float sc, LAS float* scr, int lane) {
    const int k0 = 64 * kb;
#pragma unroll 8
    for (int i = 0; i < 32; ++i) { const int kk = 2 * i + (lane >> 5); scr[kk * 33 + (lane & 31)] = __builtin_nontemporal_load(W + (size_t)(k0 + kk) * N + n0 + (lane & 31)); }
    asm volatile("s_waitcnt lgkmcnt(0)" ::: "memory");
    const int c = lane & 7;
#pragma unroll
    for (int j = 0; j < 4; ++j) { const int n = (lane >> 3) + 8 * j; const LAS float* s = scr + (8 * c) * 33 + n;
        v4u o; o.x = pk2(s[0 * 33] * sc, s[1 * 33] * sc); o.y = pk2(s[2 * 33] * sc, s[3 * 33] * sc); o.z = pk2(s[4 * 33] * sc, s[5 * 33] * sc); o.w = pk2(s[6 * 33] * sc, s[7 * 33] * sc);
        __builtin_nontemporal_store(o, (v4u*)(WT + (size_t)(drow0 + n) * K + k0 + 8 * c)); }
    asm volatile("s_waitcnt lgkmcnt(0)" ::: "memory");
}
__device__ __forceinline__ int pair_row(int n0, int F) { const int j0 = n0 < F ? n0 : n0 - F; return 256 * (j0 >> 7) + (j0 & 127) + (n0 < F ? 0 : 128); }

constexpr int I_FFI = 32 * 352, I_FFO = 88 * 64, I_GLU = 32 * 128, I_MLI = 32 * 193, I_MLO = 32 * 64;
constexpr int TRG_S5 = I_GLU + I_FFI + I_FFO, TRG_ML = I_MLI + I_MLO + I_FFI + I_FFO;
constexpr int TR_L1 = TRG_S5, TR_L2 = TR_L1 + TRG_ML, TR_L3 = TR_L2 + TRG_S5, TR_END = TR_L3 + TRG_ML;
struct TrItem { const float* W; bf16* WT; int K, N, kb, n0, drow0; float sc; };
__device__ __forceinline__ int pair_row_(int n0, int F) { const int j0 = n0 < F ? n0 : n0 - F; return 256 * (j0 >> 7) + (j0 & 127) + (n0 < F ? 0 : 128); }
__device__ __forceinline__ TrItem tr_decode(const float* w_ffi, const float* w_ffo, const float* w_glu, const float* w_mli, const float* w_mlo, unsigned char* ws, int it) {
    TrItem t; int layer, r; t.sc = 1.0f;
    if (it < TR_L1) { layer = 0; r = it; } else if (it < TR_L2) { layer = 1; r = it - TR_L1; } else if (it < TR_L3) { layer = 2; r = it - TR_L2; } else { layer = 3; r = it - TR_L3; }
    const int j = layer >> 1;
    if ((layer & 1) == 0) {
        if (r < I_GLU) { t.W = w_glu + (size_t)j * D * 2 * D; t.WT = (bf16*)(ws + WS_WGLU + j * SZ_WGLU); t.K = D; t.N = 2 * D; t.kb = r / 128; t.n0 = 32 * (r % 128); t.drow0 = pair_row_(t.n0, D); t.sc = t.n0 < D ? 1.0f : -1.4426950408889634f; return t; }
        r -= I_GLU;
    } else {
        if (r < I_MLI) { t.W = w_mli + (size_t)j * D * MLIN; t.WT = (bf16*)(ws + WS_WMLI + j * SZ_WMLI); t.K = D; t.N = MLIN; t.kb = r / 193; t.n0 = 32 * (r % 193); t.drow0 = t.n0; return t; }
        r -= I_MLI;
        if (r < I_MLO) { t.W = w_mlo + (size_t)j * D * D; t.WT = (bf16*)(ws + WS_WMLO + j * SZ_WMLO); t.K = D; t.N = D; t.kb = r / 64; t.n0 = 32 * (r % 64); t.drow0 = t.n0; return t; }
        r -= I_MLO;
    }
    if (r < I_FFI) { t.W = w_ffi + (size_t)layer * D * 2 * FF; t.WT = (bf16*)(ws + WS_WFFI + layer * SZ_WFFI); t.K = D; t.N = 2 * FF; t.kb = r / 352; t.n0 = 32 * (r % 352); t.drow0 = pair_row_(t.n0, FF); t.sc = t.n0 < FF ? 1.4426950408889634f : 0.6931471805599453f; return t; }
    r -= I_FFI;
    t.W = w_ffo + (size_t)layer * FF * D; t.WT = (bf16*)(ws + WS_WFFO + layer * SZ_WFFO); t.K = FF; t.N = D; t.kb = r / 64; t.n0 = 32 * (r % 64); t.drow0 = t.n0; return t;
}
#ifndef TQ_G
#define TQ_G 13
#endif
#ifndef TQ_F
#define TQ_F 11
#endif
#ifndef TQ_M
#define TQ_M 11
#endif
constexpr int imin(int a, int b) { return a < b ? a : b; }
constexpr int imax(int a, int b) { return a > b ? a : b; }
constexpr int CAP_G = 192 * 8 * TQ_G, CAP_F = 80 * 8 * TQ_F, CAP_M = 92 * 8 * TQ_M;
constexpr int TAIL_GLU0_LO = TR_L1,        TAIL_GLU0_HI = imin(TAIL_GLU0_LO + CAP_G, TR_END);
constexpr int TAIL_FFI0_LO = TAIL_GLU0_HI, TAIL_FFI0_HI = imin(TAIL_FFI0_LO + CAP_F, TR_END);
constexpr int E1_LO = imin(TAIL_FFI0_HI, TR_L2), E1_HI = TR_L2;
constexpr int TAIL_MLI1_LO = imax(TAIL_FFI0_HI, TR_L2), TAIL_MLI1_HI = imin(TAIL_MLI1_LO + CAP_M, TR_END);
constexpr int TAIL_FFI1_LO = TAIL_MLI1_HI, TAIL_FFI1_HI = imin(TAIL_FFI1_LO + CAP_F, TR_END);
constexpr int E2_LO = imin(TAIL_FFI1_HI, TR_L3), E2_HI = TR_L3;
constexpr int TAIL_GLU2_LO = imax(TAIL_FFI1_HI, TR_L3), TAIL_GLU2_HI = imin(TAIL_GLU2_LO + CAP_G, TR_END);
constexpr int TAIL_FFI2_LO = TAIL_GLU2_HI, TAIL_FFI2_HI = imin(TAIL_FFI2_LO + CAP_F, TR_END);
constexpr int E3_LO = TAIL_FFI2_HI, E3_HI = TR_END;
constexpr int PRO_N = TR_L1 + (E1_HI - E1_LO) + (E2_HI - E2_LO) + (E3_HI - E3_LO);
__device__ __forceinline__ int pro_item(int it) {
    if (it < TR_L1) return it; it -= TR_L1;
    if (it < E1_HI - E1_LO) return E1_LO + it; it -= E1_HI - E1_LO;
    if (it < E2_HI - E2_LO) return E2_LO + it; it -= E2_HI - E2_LO;
    return E3_LO + it;
}
struct Ctx {
    const float* in[24]; unsigned char* ws;
    LAS unsigned char* lds; int tid, lane, wave, vcu, G, bx;
};

__device__ __forceinline__ void phase_prologue(const Ctx& c) {
    LAS float* scr = (LAS float*)(c.lds + c.wave * 16384);
    const int gw = c.vcu * NWAVES + c.wave, NGW = c.G * NWAVES;
#ifndef PROBE_PRO
#define PROBE_PRO 0
#endif
    for (int rpp = 0; rpp < ((PROBE_PRO & 1) ? 2 : 1); ++rpp)
    for (int it = gw; it < PRO_N; it += NGW) { const int idx = pro_item(it);
        const TrItem t = tr_decode(c.in[22], c.in[23], c.in[17], c.in[18], c.in[21], c.ws, idx);
        transpose_item(t.W, t.K, t.N, t.WT, t.kb, t.n0, t.drow0, t.sc, scr, c.lane); }
    { const int gt = c.vcu * 512 + c.tid, NGT = c.G * 512; constexpr int PADV = (MLINP - MLIN) * D * 2 / 16;
        for (int i = gt; i < 2 * PADV; i += NGT) { const int l = i / PADV, v = i % PADV; *(v4u*)(c.ws + WS_WMLI + l * SZ_WMLI + (size_t)MLIN * D * 2 + (size_t)v * 16) = (v4u){0u, 0u, 0u, 0u}; } }
    __syncthreads();
    LAS float* sc = (LAS float*)c.lds;
    LAS float* red = (LAS float*)(c.lds + 40960);
    for (int i = c.tid; i < 5 * D; i += 512) { const int r = i / D, k = i % D; const float cv = r < 4 ? c.in[1][r * D + k] : c.in[3][k]; sc[i] = cv * fsigmoid(cv); }
    __syncthreads();
    const int cl = c.tid & 15, kg = c.tid >> 4;
    float* mod = (float*)(c.ws + WS_MOD);
    for (int rpa = 0; rpa < ((PROBE_PRO & 2) ? 2 : 1); ++rpa)
    for (int u = c.vcu; u < 768; u += c.G) {
        const int layer = u / 192, cb = u % 192;
        const float* W = c.in[4] + (size_t)layer * D * 6 * D + cb * 64 + cl * 4;
        float acc[5][4];
#pragma unroll
        for (int r = 0; r < 5; ++r)
#pragma unroll
            for (int e = 0; e < 4; ++e) acc[r][e] = 0.f;
#pragma unroll 8
        for (int kk = 0; kk < 64; ++kk) { const int k = kg + 32 * kk; const f32x4 w = __builtin_nontemporal_load((const f32x4*)(W + (size_t)k * (6 * D)));
#pragma unroll
            for (int r = 0; r < 5; ++r) { const float s = sc[r * D + k];
#pragma unroll
                for (int e = 0; e < 4; ++e) acc[r][e] += s * w[e]; } }
#pragma unroll
        for (int r = 0; r < 5; ++r)
#pragma unroll
            for (int e = 0; e < 4; ++e) red[(r * 4 + e) * 512 + c.tid] = acc[r][e];
        __syncthreads();
        if (c.tid < 320) { const int r = c.tid / 64, cc = c.tid % 64, cl2 = cc >> 2, e = cc & 3; float s = 0.f;
#pragma unroll 8
            for (int g = 0; g < 32; ++g) s += red[(r * 4 + e) * 512 + g * 16 + cl2];
            const int col = cb * 64 + cc; mod[(size_t)(layer * 5 + r) * 6 * D + col] = s + c.in[5][layer * 6 * D + col]; }
        __syncthreads();
    }
}

__device__ __forceinline__ void tr_issue(const TrItem& t, float (&rt)[32], int lane) {
    const float* wp = t.W + (size_t)(64 * t.kb + (lane >> 5)) * t.N + t.n0 + (lane & 31);
#pragma unroll
    for (int i = 0; i < 32; ++i) rt[i] = __builtin_nontemporal_load(wp + (size_t)(2 * i) * t.N);
}
__device__ __forceinline__ void tr_finish(const TrItem& t, const float (&rt)[32], LAS float* scr, int lane) {
#pragma unroll
    for (int i = 0; i < 32; ++i) scr[(2 * i + (lane >> 5)) * 33 + (lane & 31)] = rt[i];
    asm volatile("s_waitcnt lgkmcnt(0)" ::: "memory");
    const int cidx = lane & 7, k0 = 64 * t.kb; const float sc = t.sc;
#pragma unroll
    for (int j = 0; j < 4; ++j) { const int n = (lane >> 3) + 8 * j; const LAS float* s = scr + (8 * cidx) * 33 + n;
        v4u o; o.x = pk2(s[0 * 33] * sc, s[1 * 33] * sc); o.y = pk2(s[2 * 33] * sc, s[3 * 33] * sc); o.z = pk2(s[4 * 33] * sc, s[5 * 33] * sc); o.w = pk2(s[6 * 33] * sc, s[7 * 33] * sc);
        __builtin_nontemporal_store(o, (v4u*)(t.WT + (size_t)(t.drow0 + n) * t.K + k0 + 8 * cidx)); }
    asm volatile("s_waitcnt lgkmcnt(0)" ::: "memory");
}
#define TR_DEC(i_) tr_decode(c.in[22], c.in[23], c.in[17], c.in[18], c.in[21], c.ws, (i_))
__device__ __forceinline__ void tail_convert(const Ctx& c, int nunits, int lo, int hi) {
    const int nfull = nunits % c.G;
    if (nfull == 0 || c.bx < nfull || lo >= hi) return;
    LAS float* scr = (LAS float*)(c.lds + c.wave * 16384);
    const int wv = (c.bx - nfull) * NWAVES + c.wave, nwv = (c.G - nfull) * NWAVES;
    float rtA[32], rtB[32];
    int ia = lo + wv, ib = ia + nwv;
    if (ia < hi) { const TrItem t = TR_DEC(ia); tr_issue(t, rtA, c.lane); }
    if (ib < hi) { const TrItem t = TR_DEC(ib); tr_issue(t, rtB, c.lane); }
    while (ia < hi) {
        { const TrItem t = TR_DEC(ia); tr_finish(t, rtA, scr, c.lane); } ia += 2 * nwv; if (ia < hi) { const TrItem t = TR_DEC(ia); tr_issue(t, rtA, c.lane); }
        if (ib < hi) { { const TrItem t = TR_DEC(ib); tr_finish(t, rtB, scr, c.lane); } ib += 2 * nwv; if (ib < hi) { const TrItem t = TR_DEC(ib); tr_issue(t, rtB, c.lane); } }
    }
}
#undef TR_DEC

template <bool SRC32> struct NormRaw;
template <> struct NormRaw<true> { f32x4 q[8]; };
template <> struct NormRaw<false> { v2u q[8]; };
template <bool SRC32> __device__ __forceinline__ void norm_loadrow(NormRaw<SRC32>& w, const void* ctxsrc, const void* latsrc, int R, int lane) {
    if constexpr (SRC32) { const float* xr = (R < NRC ? (const float*)ctxsrc + (size_t)R * D : (const float*)latsrc + (size_t)(R - NRC) * D) + 4 * lane;
#pragma unroll
        for (int j = 0; j < 8; ++j) w.q[j] = __builtin_nontemporal_load((const f32x4*)(xr + 256 * j)); }
    else { const bf16* xr = (R < NRC ? (const bf16*)ctxsrc + (size_t)R * D : (const bf16*)latsrc + (size_t)(R - NRC) * D) + 4 * lane;
#pragma unroll
        for (int j = 0; j < 8; ++j) w.q[j] = __builtin_nontemporal_load((const v2u*)(xr + 256 * j)); }
}
template <bool SRC32> __device__ __forceinline__ f32x4 norm_cvt(const NormRaw<SRC32>& w, int j) {
    if constexpr (SRC32) return w.q[j]; else return (f32x4){bflo(w.q[j].x), bfhi(w.q[j].x), bflo(w.q[j].y), bfhi(w.q[j].y)};
}
template <bool MLP, bool SRC32> __device__ __forceinline__ void phase_norm(const Ctx& c, const void* ctxsrc, const void* latsrc, const float* g, const float* modl, int shift_idx, int scale_idx, bf16* U, const bf16* slab, bf16* Xw, int r_lo) {
    LAS float* wn = (LAS float*)c.lds; LAS float* sh = (LAS float*)(c.lds + 40960);
    __syncthreads();
    for (int i = c.tid; i < 5 * D; i += 512) { const int r = i / D, col = i % D; wn[i] = g[col] * (1.0f + modl[(size_t)(r * 6 + scale_idx) * D + col]); sh[i] = modl[(size_t)(r * 6 + shift_idx) * D + col]; }
    __syncthreads();
    const int gw = c.vcu * NWAVES + c.wave, NGW = c.G * NWAVES;
    int R = r_lo + gw;
    NormRaw<SRC32> w0, w1;
    if (R < NR) norm_loadrow<SRC32>(w0, ctxsrc, latsrc, R, c.lane);
    if (R + NGW < NR) norm_loadrow<SRC32>(w1, ctxsrc, latsrc, R + NGW, c.lane);
    while (R < NR) {
        NormRaw<SRC32> w2;
        if (R + 2 * NGW < NR) norm_loadrow<SRC32>(w2, ctxsrc, latsrc, R + 2 * NGW, c.lane);
        f32x4 v[8];
#pragma unroll
        for (int j = 0; j < 8; ++j) v[j] = norm_cvt<SRC32>(w0, j);
        int r, dstR;
        if (R < NRC) { r = 4; dstR = R;
            if (slab) {
#pragma unroll
                for (int sidx = 0; sidx < 8; ++sidx) { const bf16* sp = slab + ((size_t)sidx * NRC + R) * D + 4 * c.lane;
#pragma unroll
                    for (int j = 0; j < 8; ++j) { const v2u pw = __builtin_nontemporal_load((const v2u*)(sp + 256 * j)); v[j] += (f32x4){bflo(pw.x), bfhi(pw.x), bflo(pw.y), bfhi(pw.y)}; } }
#pragma unroll
                for (int j = 0; j < 8; ++j) { v2u xw; xw.x = pk2(v[j][0], v[j][1]); xw.y = pk2(v[j][2], v[j][3]); *(v2u*)(Xw + (size_t)R * D + 4 * c.lane + 256 * j) = xw; } } }
        else { const int q = R - NRC, s = q & 4095; r = q >> 12; dstR = MLP ? NRC + (q & ~4095) + ((s & 63) << 6) + (s >> 6) : R; }
        float ss = 0.f;
#pragma unroll
        for (int j = 0; j < 8; ++j) ss += (v[j][0] * v[j][0] + v[j][1] * v[j][1]) + (v[j][2] * v[j][2] + v[j][3] * v[j][3]);
        const float rs = 1.0f / sqrtf(wave_sum(ss) * (1.0f / D) + EPSN);
        bf16* orow = U + (size_t)dstR * D;
#pragma unroll
        for (int j = 0; j < 8; ++j) { const int col = 4 * c.lane + 256 * j; const f32x4 ww = *(const LAS f32x4*)(wn + r * D + col), hv = *(const LAS f32x4*)(sh + r * D + col);
            v2u w; w.x = pk2(v[j][0] * rs * ww[0] + hv[0], v[j][1] * rs * ww[1] + hv[1]); w.y = pk2(v[j][2] * rs * ww[2] + hv[2], v[j][3] * rs * ww[3] + hv[3]); *(v2u*)(orow + col) = w; }
        w0 = w1; w1 = w2;
        R += NGW;
    }
}
__device__ __forceinline__ void phase_final(const Ctx& c, const bf16* X, const float* g, float* out) {
    const int gw = c.vcu * NWAVES + c.wave, NGW = c.G * NWAVES;
    int q = gw; NormRaw<false> w0, w1;
    const bf16* XL = X + (size_t)NRC * D;
    if (q < NRL) norm_loadrow<false>(w0, XL, XL, NRC + q, c.lane);
    if (q + NGW < NRL) norm_loadrow<false>(w1, XL, XL, NRC + q + NGW, c.lane);
    while (q < NRL) {
        NormRaw<false> w2;
        if (q + 2 * NGW < NRL) norm_loadrow<false>(w2, XL, XL, NRC + q + 2 * NGW, c.lane);
        f32x4 v[8];
#pragma unroll
        for (int j = 0; j < 8; ++j) v[j] = norm_cvt<false>(w0, j);
        float ss = 0.f;
#pragma unroll
        for (int j = 0; j < 8; ++j) ss += (v[j][0] * v[j][0] + v[j][1] * v[j][1]) + (v[j][2] * v[j][2] + v[j][3] * v[j][3]);
        const float rs = 1.0f / sqrtf(wave_sum(ss) * (1.0f / D) + EPSN);
#pragma unroll
        for (int j = 0; j < 8; ++j) { const int col = 4 * c.lane + 256 * j; const f32x4 gg = *(const f32x4*)(g + col); __builtin_nontemporal_store(v[j] * rs * gg, (f32x4*)(out + (size_t)q * D + col)); }
        w0 = w1; w1 = w2;
        q += NGW;
    }
}

__device__ __forceinline__ int s5_rowbase(int b, int dir, int bi) {
    if (bi < 16) { const int cb = dir ? 15 - bi : bi; return b * 256 + cb * 16; }
    const int cb0 = bi - 16, cb = dir ? 255 - cb0 : cb0; return NRC + b * 4096 + cb * 16;
}
typedef float f32x16 __attribute__((ext_vector_type(16)));
__device__ __forceinline__ void phase_s5_scan3(const Ctx& c, int j, const bf16* U, bf16* YF, bf16* YB) {
    const float* lam_re = c.in[9]; const float* lam_im = c.in[10]; const float* log_dt = c.in[11];
    const float* b_re = c.in[12]; const float* b_im = c.in[13]; const float* c_re = c.in[14]; const float* c_im = c.in[15];
    const int lane = c.lane, w = c.wave, r = lane & 31, hh = lane >> 5, l15 = lane & 15, g4 = lane >> 4;
    for (int u = c.vcu; u < 256; u += c.G) {
        const int g = u >> 1, dir = u & 1;
        const size_t pg = (size_t)(j * 2 + dir) * 128 + g;
        bf16* Y = dir ? YB : YF;
        __syncthreads();
        if (w < 4) {
            __builtin_amdgcn_s_setprio(2);
            const int bp = w >> 1, sg = w & 1, p = 32 * sg + r, bme = 2 * bp + hh;
            const float dt = expf(log_dt[pg]);
            const float lre = lam_re[pg * 64 + p], lim = lam_im[pg * 64 + p];
            const float mag = expf(lre * dt); float sn, cs; sincosf(lim * dt, &sn, &cs);
            const float are = mag * cs, aim = mag * sn;
            const float den = lre * lre + lim * lim;
            const float fre = ((are - 1.0f) * lre + aim * lim) / den, fim = (aim * lre - (are - 1.0f) * lim) / den;
            bf16x8 Bfr, Bfi;
            { const f32x4 br0 = *(const f32x4*)(b_re + (pg * 64 + p) * 16 + 8 * hh), br1 = *(const f32x4*)(b_re + (pg * 64 + p) * 16 + 8 * hh + 4);
              const f32x4 bi0 = *(const f32x4*)(b_im + (pg * 64 + p) * 16 + 8 * hh), bi1 = *(const f32x4*)(b_im + (pg * 64 + p) * 16 + 8 * hh + 4);
#pragma unroll
              for (int e = 0; e < 4; ++e) { Bfr[e] = (short)f2bf(fre * br0[e] - fim * bi0[e]); Bfr[4 + e] = (short)f2bf(fre * br1[e] - fim * bi1[e]);
                  Bfi[e] = (short)f2bf(fre * bi0[e] + fim * br0[e]); Bfi[4 + e] = (short)f2bf(fre * bi1[e] + fim * br1[e]); } }
            const int hrow = (r >> 2) & 1, tst = 4 * (r >> 3) + (r & 3), toff = dir ? 15 - tst : tst, brow = 2 * bp + hrow;
            const bf16* up = U + (size_t)g * 16 + 8 * hh;
            bf16x8 ring[8];
#pragma unroll
            for (int k = 0; k < 8; ++k) ring[k] = *(const bf16x8*)(up + (size_t)(s5_rowbase(brow, dir, k) + toff) * D);
            float sre = 0.f, sim = 0.f;
            f32x16 z;
#pragma unroll
            for (int e = 0; e < 16; ++e) z[e] = 0.f;
            f32x16 hrn = __builtin_amdgcn_mfma_f32_32x32x16_bf16(ring[0], Bfr, z, 0, 0, 0), hin = __builtin_amdgcn_mfma_f32_32x32x16_bf16(ring[0], Bfi, z, 0, 0, 0);
            ring[0] = *(const bf16x8*)(up + (size_t)(s5_rowbase(brow, dir, 8) + toff) * D);
            const int sg16 = dir ? -16 : 16, dS = NRC + brow * 3840 + (dir ? 4080 : -240);
            const bf16* upn = up + (size_t)(s5_rowbase(brow, dir, 9) + toff) * D; int nb = 9;
            for (int bb = 0; bb < 272; bb += 8) {
#pragma unroll
              for (int k = 0; k < 8; ++k) {
                const int bi = bb + k;
                const f32x16 hr = hrn, hi = hin;
                { const int kn = (k + 1) & 7; const bf16x8 unx = ring[kn];
                  hrn = __builtin_amdgcn_mfma_f32_32x32x16_bf16(unx, Bfr, z, 0, 0, 0); hin = __builtin_amdgcn_mfma_f32_32x32x16_bf16(unx, Bfi, z, 0, 0, 0);
                  ring[kn] = *(const bf16x8*)upn;
                  if (nb < 271) { const long dr = nb == 15 ? dS : sg16; upn += dr * D; ++nb; } }
                LAS unsigned char* hb = c.lds + (bme * 2 + ((bi >> 1) & 1)) * 8704 + (bi & 1) * 4352 + 4 * p;
#pragma unroll
                for (int e = 0; e < 16; ++e) { float nre = fmaf(are, sre, fmaf(-aim, sim, hr[e])); asm volatile("" : "+v"(nre));
                    const float nim = fmaf(are, sim, fmaf(aim, sre, hi[e])); sre = nre; sim = nim;
                    *(LAS unsigned*)(hb + e * 272) = pg8::cvt_pk_bf16(nre, nim); }
                if (k & 1) __syncthreads();
              }
            }
            __builtin_amdgcn_s_setprio(0);
        } else {
            const int bq = w - 4;
            bf16x8 Cf[4];
#pragma unroll
            for (int ks = 0; ks < 4; ++ks) { const int p0 = 16 * ks + 4 * g4; const f32x4 cr = *(const f32x4*)(c_re + (pg * 16 + l15) * 64 + p0), ci = *(const f32x4*)(c_im + (pg * 16 + l15) * 64 + p0);
#pragma unroll
                for (int e = 0; e < 4; ++e) { Cf[ks][2 * e] = (short)f2bf(cr[e]); Cf[ks][2 * e + 1] = (short)f2bf(-ci[e]); } }
            const int sg16 = dir ? -16 : 16, dS = NRC + bq * 3840 + (dir ? 4080 : -240);
            bf16* yp = Y + (size_t)(s5_rowbase(bq, dir, 0) + (dir ? 15 - l15 : l15)) * D + g * 16 + 4 * g4;
            for (int bp2 = 0; bp2 < 136; ++bp2) {
                __syncthreads();
#pragma unroll
                for (int hf2 = 0; hf2 < 2; ++hf2) {
                    const int bi = 2 * bp2 + hf2;
                    const LAS unsigned char* hb = c.lds + (bq * 2 + (bp2 & 1)) * 8704 + hf2 * 4352;
                    f32x4 acc = {0.f, 0.f, 0.f, 0.f};
#pragma unroll
                    for (int ks = 0; ks < 4; ++ks) { const bf16x8 hf = *(const LAS bf16x8*)(hb + l15 * 272 + ks * 64 + g4 * 16);
                        acc = __builtin_amdgcn_mfma_f32_16x16x32_bf16(Cf[ks], hf, acc, 0, 0, 0); }
                    *(v2u*)yp = (v2u){pg8::cvt_pk_bf16(acc[0], acc[1]), pg8::cvt_pk_bf16(acc[2], acc[3])};
                    { const long dr = bi == 15 ? dS : sg16; yp += dr * D; }
                }
            }
        }
    }
}

__device__ __forceinline__ v4u s5_comb_item(v4u uw, v4u fw, v4u bw, f32x4 d0, f32x4 d1) {
    float y[8];
    y[0] = d0[0] * bflo(uw.x) + bflo(fw.x) + bflo(bw.x); y[1] = d0[1] * bfhi(uw.x) + bfhi(fw.x) + bfhi(bw.x); y[2] = d0[2] * bflo(uw.y) + bflo(fw.y) + bflo(bw.y); y[3] = d0[3] * bfhi(uw.y) + bfhi(fw.y) + bfhi(bw.y);
    y[4] = d1[0] * bflo(uw.z) + bflo(fw.z) + bflo(bw.z); y[5] = d1[1] * bfhi(uw.z) + bfhi(fw.z) + bfhi(bw.z); y[6] = d1[2] * bflo(uw.w) + bflo(fw.w) + bflo(bw.w); y[7] = d1[3] * bfhi(uw.w) + bfhi(fw.w) + bfhi(bw.w);
#pragma unroll
    for (int e = 0; e < 8; ++e) { const float x = y[e]; const float z = 0.7978845608028654f * (x + 0.044715f * x * x * x); y[e] = x * fsigmoid(2.0f * z); }
    v4u w; w.x = pk2(y[0], y[1]); w.y = pk2(y[2], y[3]); w.z = pk2(y[4], y[5]); w.w = pk2(y[6], y[7]); return w;
}
__device__ __forceinline__ void phase_s5_combine(const Ctx& c, const float* dsk, const bf16* U, const bf16* YF, const bf16* YB, bf16* Gout) {
    const int gt = c.vcu * 512 + c.tid, NGT = c.G * 512; constexpr int NIT = NR * (D / 8);
    for (int i = gt; i < NIT; i += 2 * NGT) {
        const int i1 = i + NGT; const bool has1 = i1 < NIT;
        const size_t o0 = (size_t)i * 8, o1 = (size_t)(has1 ? i1 : i) * 8; const int c0 = (int)(o0 & (D - 1)), c1 = (int)(o1 & (D - 1));
        const v4u u0 = __builtin_nontemporal_load((const v4u*)(U + o0)), f0 = __builtin_nontemporal_load((const v4u*)(YF + o0)), b0 = __builtin_nontemporal_load((const v4u*)(YB + o0)),
                  u1 = __builtin_nontemporal_load((const v4u*)(U + o1)), f1 = __builtin_nontemporal_load((const v4u*)(YF + o1)), b1 = __builtin_nontemporal_load((const v4u*)(YB + o1));
        const f32x4 d00 = *(const f32x4*)(dsk + c0), d01 = *(const f32x4*)(dsk + c0 + 4), d10 = *(const f32x4*)(dsk + c1), d11 = *(const f32x4*)(dsk + c1 + 4);
        const v4u w0 = s5_comb_item(u0, f0, b0, d00, d01), w1 = s5_comb_item(u1, f1, b1, d10, d11);
        *(v4u*)(Gout + o0) = w0; if (has1) *(v4u*)(Gout + o1) = w1;
    }
}

typedef short s16x4 __attribute__((ext_vector_type(4)));
__device__ __forceinline__ bf16x8 tr_frag(LAS unsigned char* p0, LAS unsigned char* p1) {
    const s16x4 a = __builtin_amdgcn_ds_read_tr16_b64_v4i16((LAS s16x4*)p0), b = __builtin_amdgcn_ds_read_tr16_b64_v4i16((LAS s16x4*)p1);
    return __builtin_shufflevector(a, b, 0, 1, 2, 3, 4, 5, 6, 7);
}
__device__ __forceinline__ float fexp(float x) { return __builtin_amdgcn_exp2f(1.4426950408889634f * x); }
__device__ __forceinline__ int mlc_rowbase(int b, int dir, int cc) {
    if (cc < 4) { const int nc = dir ? 3 - cc : cc; return b * 256 + 64 * nc; }
    const int n0 = cc - 4, nc = dir ? 63 - n0 : n0; return NRC + b * 4096 + 64 * nc;
}
#define DPP_F(oldv, src, ctrl, rmask) __builtin_bit_cast(float, __builtin_amdgcn_update_dpp(__builtin_bit_cast(int, (float)(oldv)), __builtin_bit_cast(int, (float)(src)), (ctrl), (rmask), 0xf, false))
__device__ __forceinline__ float wave_scan_add(float x) {
    x += DPP_F(0.f, x, 0x111, 0xf); x += DPP_F(0.f, x, 0x112, 0xf); x += DPP_F(0.f, x, 0x114, 0xf); x += DPP_F(0.f, x, 0x118, 0xf);
    x += DPP_F(0.f, x, 0x142, 0xa); x += DPP_F(0.f, x, 0x143, 0xc); return x; }
__device__ __forceinline__ float wave_scan_max(float x) {
    const float NI = -__builtin_inff();
    x = fmaxf(x, DPP_F(NI, x, 0x111, 0xf)); x = fmaxf(x, DPP_F(NI, x, 0x112, 0xf)); x = fmaxf(x, DPP_F(NI, x, 0x114, 0xf)); x = fmaxf(x, DPP_F(NI, x, 0x118, 0xf));
    x = fmaxf(x, DPP_F(NI, x, 0x142, 0xa)); x = fmaxf(x, DPP_F(NI, x, 0x143, 0xc)); return x; }
__device__ __forceinline__ void phase_mlstm_chunk2(const Ctx& c, const bf16* Q, const bf16* K, const bf16* V, const float* GATES, bf16* HF, bf16* HB) {
    constexpr int QS = 0, KS = 17408, KWS = 34816  , VS = 69632  , PS = 87040, CB = 96256, NV = 113664, QN = 114176, GL = 114432  , NP = 115456  , PRIV = 119552;
    static_assert(PRIV + 8 * 1280 <= RING_BYTES && NP + 8 * 128 * 4 <= PRIV, "mLSTM chunk LDS map");
    LAS unsigned char* L = c.lds;
    const int tid = c.tid, lane = c.lane, w = c.wave, l15 = lane & 15, g4 = lane >> 4, qq = l15 >> 2, pp = l15 & 3;
    const int et = w & 3, ih = w >> 2;
    LAS float* priv = (LAS float*)(L + PRIV + w * 1280);
    const int srow = tid >> 3, spc = tid & 7;
    bf16x8 ones;
#pragma unroll
    for (int e = 0; e < 8; ++e) ones[e] = (short)0x3F80;
    for (int u = c.vcu; u < 256; u += c.G) {
        const int es = u & 3, dir = (u >> 2) & 1, h = (u >> 3) & 7, b = u >> 6;
        bf16* HOUT = dir ? HB : HF;
        __syncthreads();
        for (int i = tid; i < 17408 / 4; i += 512) ((LAS unsigned*)(L + CB))[i] = 0u;
        if (tid < 128) ((LAS float*)(L + NV))[tid] = 0.f;
        f32x4 Cacc[4];
#pragma unroll
        for (int j = 0; j < 4; ++j) Cacc[j] = (f32x4){0.f, 0.f, 0.f, 0.f};
        float m = 0.f;
        v4u rq0, rq1, rk0, rk1, rv; float rg = 0.f;
        const int sgn64 = dir ? -64 : 64, dB = NRC + b * 3840 + (dir ? 4032 : -192);
        int lc = 0, gc = 0;
        const bf16 *qp, *kp, *vp; const float* gp; bf16* hp[2];
        { const size_t R0_ = (size_t)(mlc_rowbase(b, dir, 0) + (dir ? 63 - srow : srow)); qp = Q + R0_ * 1024 + h * 128 + spc * 16; kp = K + R0_ * 1024 + h * 128 + spc * 16; vp = V + R0_ * D + h * 256 + es * 64 + spc * 8;
          const int s_ = tid & 63, wh_ = (tid >> 6) & 1; gp = GATES + (size_t)(mlc_rowbase(b, dir, 0) + (dir ? 63 - s_ : s_)) * 32 + (2 * dir + wh_) * 8 + h;
#pragma unroll
          for (int t = 0; t < 2; ++t) { const int i = 16 * (2 * ih + t) + l15; hp[t] = HOUT + (size_t)(mlc_rowbase(b, dir, 0) + (dir ? 63 - i : i)) * D + h * 256 + es * 64 + 16 * et + 4 * g4; } }
#define MLC_LOAD(cc_) do { rq0 = *(const v4u*)qp; rq1 = *(const v4u*)(qp + 8); rk0 = *(const v4u*)kp; rk1 = *(const v4u*)(kp + 8); rv = *(const v4u*)vp; \
            const long dr_ = (lc == 3) ? dB : sgn64; qp += dr_ * 1024; kp += dr_ * 1024; vp += dr_ * D; ++lc; } while (0)
#define MLC_LOADG(cc_) do { if (tid < 128) rg = *gp; const long dr_ = (gc == 3) ? dB : sgn64; gp += dr_ * 32; ++gc; } while (0)
#define MLC_STOREG(buf_) do { if (tid < 128) ((LAS float*)(L + GL + (buf_) * 512))[tid] = rg; } while (0)
        MLC_LOADG(0); MLC_STOREG(0); MLC_LOADG(1);
        MLC_LOAD(0);
        __syncthreads();
        float decay = 0.f, wgr_n = 0.f; v4u ck0 = {0u, 0u, 0u, 0u}, ck1 = {0u, 0u, 0u, 0u};
        auto secA = [&](const int cn) __attribute__((always_inline)) {
            const int db = cn & 1;
            LAS unsigned char* KWb = L + KWS + db * 17408; LAS unsigned char* Vb_ = L + VS + db * 8704;
            *(LAS v4u*)(L + QS + srow * 272 + spc * 32) = rq0; *(LAS v4u*)(L + QS + srow * 272 + spc * 32 + 16) = rq1;
            *(LAS v4u*)(L + KS + srow * 272 + spc * 32) = rk0; *(LAS v4u*)(L + KS + srow * 272 + spc * 32 + 16) = rk1;
            *(LAS v2u*)(Vb_ + srow * 136 + spc * 16) = (v2u){rv.x, rv.y}; *(LAS v2u*)(Vb_ + srow * 136 + spc * 16 + 8) = (v2u){rv.z, rv.w};
            ck0 = rk0; ck1 = rk1;
            MLC_STOREG(db ^ 1);
            if (cn + 1 < 68) MLC_LOAD(cn + 1);
            if (cn + 2 < 68) MLC_LOADG(cn + 2);
            { const float li = ((LAS float*)(L + GL + db * 512))[lane], lf = ((LAS float*)(L + GL + db * 512))[64 + lane];
                const float bc = wave_scan_add(lf);
                const float a = li - bc; const float pm = wave_scan_max(a);
                const float M = fmaxf(m, pm);
                const float M63 = __builtin_bit_cast(float, __builtin_amdgcn_readlane(__builtin_bit_cast(int, M), 63)), b63 = __builtin_bit_cast(float, __builtin_amdgcn_readlane(__builtin_bit_cast(int, bc), 63));
                priv[lane] = a; priv[64 + lane] = -M; priv[128 + lane] = fexp(m - M); priv[192 + lane] = fexp(-bc - M); priv[256 + lane] = fexp(a - M63);
                decay = fexp(m - M63); m = b63 + M63; }
            wgr_n = priv[256 + srow];
        };
        auto secA2 = [&](const int cn) __attribute__((always_inline)) {
            const int db = cn & 1;
            LAS unsigned char* KWb = L + KWS + db * 17408;
            { const float wgr = wgr_n;
                v4u k0, k1;
                k0.x = pg8::cvt_pk_bf16(bflo(ck0.x) * wgr, bfhi(ck0.x) * wgr); k0.y = pg8::cvt_pk_bf16(bflo(ck0.y) * wgr, bfhi(ck0.y) * wgr); k0.z = pg8::cvt_pk_bf16(bflo(ck0.z) * wgr, bfhi(ck0.z) * wgr); k0.w = pg8::cvt_pk_bf16(bflo(ck0.w) * wgr, bfhi(ck0.w) * wgr);
                k1.x = pg8::cvt_pk_bf16(bflo(ck1.x) * wgr, bfhi(ck1.x) * wgr); k1.y = pg8::cvt_pk_bf16(bflo(ck1.y) * wgr, bfhi(ck1.y) * wgr); k1.z = pg8::cvt_pk_bf16(bflo(ck1.z) * wgr, bfhi(ck1.z) * wgr); k1.w = pg8::cvt_pk_bf16(bflo(ck1.w) * wgr, bfhi(ck1.w) * wgr);
                *(LAS v4u*)(KWb + srow * 272 + spc * 32) = k0; *(LAS v4u*)(KWb + srow * 272 + spc * 32 + 16) = k1; }
        };
        secA(0); secA2(0);
        __syncthreads();
        for (int cc = 0; cc < 68; ++cc) {
            const int db = cc & 1;
            LAS unsigned char* KWb = L + KWS + db * 17408; LAS unsigned char* Vb_ = L + VS + db * 8704;
            bf16x8 qf[2][4];
            f32x4 oacc[2];
            {
#pragma unroll
                for (int t = 0; t < 2; ++t)
#pragma unroll
                    for (int ks = 0; ks < 4; ++ks) qf[t][ks] = *(const LAS bf16x8*)(L + QS + (16 * (2 * ih + t) + l15) * 272 + ks * 64 + g4 * 16);
                f32x4 sacc[2] = {(f32x4){0.f, 0.f, 0.f, 0.f}, (f32x4){0.f, 0.f, 0.f, 0.f}};
#pragma unroll
                for (int ks = 0; ks < 4; ++ks) { const bf16x8 kf = *(const LAS bf16x8*)(L + KS + (16 * et + l15) * 272 + ks * 64 + g4 * 16);
                    sacc[0] = __builtin_amdgcn_mfma_f32_16x16x32_bf16(kf, qf[0][ks], sacc[0], 0, 0, 0); sacc[1] = __builtin_amdgcn_mfma_f32_16x16x32_bf16(kf, qf[1][ks], sacc[1], 0, 0, 0); }
                oacc[0] = (f32x4){0.f, 0.f, 0.f, 0.f}; oacc[1] = (f32x4){0.f, 0.f, 0.f, 0.f};
#pragma unroll
                for (int ks = 0; ks < 4; ++ks) { const bf16x8 cf = *(const LAS bf16x8*)(L + CB + (16 * et + l15) * 272 + ks * 64 + g4 * 16);
                    oacc[0] = __builtin_amdgcn_mfma_f32_16x16x32_bf16(cf, qf[0][ks], oacc[0], 0, 0, 0); oacc[1] = __builtin_amdgcn_mfma_f32_16x16x32_bf16(cf, qf[1][ks], oacc[1], 0, 0, 0); }
                const f32x4 av = *(const LAS f32x4*)(priv + 16 * et + 4 * g4);
#pragma unroll
                for (int t = 0; t < 2; ++t) { const int i = 16 * (2 * ih + t) + l15; const float negM = priv[64 + i]; float pv4[4];
#pragma unroll
                    for (int r = 0; r < 4; ++r) { const int s = 16 * et + 4 * g4 + r; const float wgt = (s <= i) ? fexp(av[r] + negM) : 0.f; pv4[r] = sacc[t][r] * wgt; }
                    *(LAS v2u*)(L + PS + i * 144 + (16 * et + 4 * g4) * 2) = (v2u){pg8::cvt_pk_bf16(pv4[0], pv4[1]), pg8::cvt_pk_bf16(pv4[2], pv4[3])};
                    oacc[t] = oacc[t] * priv[128 + i]; }
                { const v4u a0 = *(const LAS v4u*)(L + QS + srow * 272 + spc * 32), a1 = *(const LAS v4u*)(L + QS + srow * 272 + spc * 32 + 16);
                    const LAS f32x4* np = (const LAS f32x4*)(L + NV + spc * 64); const f32x4 n0 = np[0], n1 = np[1], n2 = np[2], n3 = np[3];
                    float d = bflo(a0.x) * n0[0] + bfhi(a0.x) * n0[1] + bflo(a0.y) * n0[2] + bfhi(a0.y) * n0[3] + bflo(a0.z) * n1[0] + bfhi(a0.z) * n1[1] + bflo(a0.w) * n1[2] + bfhi(a0.w) * n1[3]
                            + bflo(a1.x) * n2[0] + bfhi(a1.x) * n2[1] + bflo(a1.y) * n2[2] + bfhi(a1.y) * n2[3] + bflo(a1.z) * n3[0] + bfhi(a1.z) * n3[1] + bflo(a1.w) * n3[2] + bfhi(a1.w) * n3[3];
                    d += DPP_F(0.f, d, 0xB1, 0xf); d += DPP_F(0.f, d, 0x4E, 0xf); d += DPP_F(0.f, d, 0x141, 0xf);
                    if (spc == 0) ((LAS float*)(L + QN))[srow] = d; }
                if (tid < 256) { const int d4 = tid & 31, rg8 = tid >> 5; f32x4 sm = {0.f, 0.f, 0.f, 0.f};
#pragma unroll
                    for (int s = 0; s < 8; ++s) { const v2u kv = *(const LAS v2u*)(KWb + (8 * rg8 + s) * 272 + d4 * 8); sm[0] += bflo(kv.x); sm[1] += bfhi(kv.x); sm[2] += bflo(kv.y); sm[3] += bfhi(kv.y); }
                    *(LAS f32x4*)(L + NP + (rg8 * 128 + 4 * d4) * 4) = sm; }
            }
            __syncthreads();
            const float dec_c = decay;
            float e128[2], e192[2], qnv[2];
#pragma unroll
            for (int t = 0; t < 2; ++t) { const int i = 16 * (2 * ih + t) + l15; e128[t] = priv[128 + i]; e192[t] = priv[192 + i]; qnv[t] = ((LAS float*)(L + QN))[i]; }
            secA(cc + 1);
            {
                bf16x8 vf[2];
#pragma unroll
                for (int ks = 0; ks < 2; ++ks) { LAS unsigned char* vp = Vb_ + (32 * ks + 8 * g4 + qq) * 136 + (16 * et + 4 * pp) * 2; vf[ks] = tr_frag(vp, vp + 4 * 136); }
                f32x4 racc[2] = {(f32x4){0.f, 0.f, 0.f, 0.f}, (f32x4){0.f, 0.f, 0.f, 0.f}};
#pragma unroll
                for (int ks = 0; ks < 2; ++ks)
#pragma unroll
                    for (int t = 0; t < 2; ++t) { const bf16x8 pf = *(const LAS bf16x8*)(L + PS + (16 * (2 * ih + t) + l15) * 144 + ks * 64 + g4 * 16);
                        oacc[t] = __builtin_amdgcn_mfma_f32_16x16x32_bf16(vf[ks], pf, oacc[t], 0, 0, 0); racc[t] = __builtin_amdgcn_mfma_f32_16x16x32_bf16(ones, pf, racc[t], 0, 0, 0); }
#pragma unroll
                for (int t = 0; t < 2; ++t) { const int i = 16 * (2 * ih + t) + l15;
                    const float den = e128[t] * qnv[t] + racc[t][0];
                    const float inv = __builtin_amdgcn_rcpf(fmaxf(fabsf(den), e192[t]));
                    const f32x4 ho = oacc[t] * inv; *(v2u*)hp[t] = (v2u){pg8::cvt_pk_bf16(ho[0], ho[1]), pg8::cvt_pk_bf16(ho[2], ho[3])}; }
                { const long dr_ = (cc == 3) ? dB : sgn64; hp[0] += dr_ * D; hp[1] += dr_ * D; }
#pragma unroll
                for (int j = 0; j < 4; ++j) Cacc[j] = Cacc[j] * dec_c;
#pragma unroll
                for (int ks = 0; ks < 2; ++ks)
#pragma unroll
                    for (int j = 0; j < 4; ++j) { LAS unsigned char* kp = KWb + (32 * ks + 8 * g4 + qq) * 272 + (16 * (4 * ih + j) + 4 * pp) * 2; const bf16x8 kwf = tr_frag(kp, kp + 4 * 272);
                        Cacc[j] = __builtin_amdgcn_mfma_f32_16x16x32_bf16(kwf, vf[ks], Cacc[j], 0, 0, 0); }
#pragma unroll
                for (int j = 0; j < 4; ++j)
                    *(LAS v2u*)(L + CB + (16 * et + l15) * 272 + (16 * (4 * ih + j) + 4 * g4) * 2) = (v2u){pg8::cvt_pk_bf16(Cacc[j][0], Cacc[j][1]), pg8::cvt_pk_bf16(Cacc[j][2], Cacc[j][3])};
                if (tid < 128) { LAS float* np = (LAS float*)(L + NP) + tid; LAS float* nv = (LAS float*)(L + NV);
                    float x0 = np[0], x1 = np[128], x2 = np[256], x3 = np[384], x4 = np[512], x5 = np[640], x6 = np[768], x7 = np[896], x8 = nv[tid];
                    asm volatile("" : "+v"(x0), "+v"(x1), "+v"(x2), "+v"(x3), "+v"(x4), "+v"(x5), "+v"(x6), "+v"(x7), "+v"(x8));
                    nv[tid] = dec_c * x8 + (((x0 + x1) + (x2 + x3)) + ((x4 + x5) + (x6 + x7))); }
            }
            secA2(cc + 1);
            __syncthreads();
        }
#undef MLC_LOAD
#undef MLC_LOADG
#undef MLC_STOREG
    }
}

__device__ __forceinline__ void phase_ml_readout(const Ctx& c, const bf16* HF, const bf16* HB, const bf16* O, const float* nw, bf16* Gout, int r_lo) {
    const int gw = c.vcu * NWAVES + c.wave, NGW = c.G * NWAVES;
    for (int R = r_lo + gw; R < NR; R += NGW) {
        int dstR = R;
        if (R >= NRC) { const int q = R - NRC, pq = q & 4095; dstR = NRC + (q & ~4095) + ((pq & 63) << 6) + (pq >> 6); }
        v2u hfw[8], hbw[8], ow[8];
#pragma unroll
        for (int j = 0; j < 8; ++j) { const size_t off = (size_t)R * D + 256 * j + 4 * c.lane; hfw[j] = __builtin_nontemporal_load((const v2u*)(HF + off)); hbw[j] = __builtin_nontemporal_load((const v2u*)(HB + off)); ow[j] = __builtin_nontemporal_load((const v2u*)(O + off)); }
        asm volatile("" ::: "memory");
#pragma unroll
        for (int j = 0; j < 8; ++j) {
            const f32x4 hs = (f32x4){bflo(hfw[j].x), bfhi(hfw[j].x), bflo(hfw[j].y), bfhi(hfw[j].y)} + (f32x4){bflo(hbw[j].x), bfhi(hbw[j].x), bflo(hbw[j].y), bfhi(hbw[j].y)};
            const float ss = wave_sum((hs[0] * hs[0] + hs[1] * hs[1]) + (hs[2] * hs[2] + hs[3] * hs[3]));
            const float rs = 1.0f / sqrtf(ss * (1.0f / 256.0f) + EPSN);
            const f32x4 w4 = *(const f32x4*)(nw + 256 * j + 4 * c.lane);
            const float o0 = hs[0] * rs * w4[0] * fsigmoid(bflo(ow[j].x)), o1 = hs[1] * rs * w4[1] * fsigmoid(bfhi(ow[j].x)), o2 = hs[2] * rs * w4[2] * fsigmoid(bflo(ow[j].y)), o3 = hs[3] * rs * w4[3] * fsigmoid(bfhi(ow[j].y));
            v2u w; w.x = pk2(o0, o1); w.y = pk2(o2, o3); *(v2u*)(Gout + (size_t)dstR * D + 256 * j + 4 * c.lane) = w; }
    }
}

struct Args { const float* in[24]; float* out; unsigned char* ws; int ph_lo, ph_hi; };
constexpr int NPHASES = 1 + 2 * 7 + 2 * 8 + 1;
typedef const float* fptr_t;
#ifndef PHSEL
#define PHSEL 0xffffffffu
#endif
__global__ void __launch_bounds__(NWAVES * 64, 2) mk_fwd(Args args) {
    extern __shared__ __attribute__((aligned(16))) unsigned char lds_raw[];
    LAS unsigned char* const lds = (LAS unsigned char*)lds_raw;
    int wave_s = __builtin_amdgcn_readfirstlane((int)threadIdx.x >> 6); asm volatile("" : "+s"(wave_s));
    { const int tid0 = wave_s * 64 + mk_lane();
      for (int u = tid0; u < (LDS_BYTES - LDSCTL_OFF) / 4; u += NWAVES * 64) ((LAS unsigned*)(lds + LDSCTL_OFF))[u] = 0u; }
    __syncthreads();
    volatile LAS unsigned* MISC = (volatile LAS unsigned*)(lds + MISC_OFF);
    XcdBarrier bar; bar.bar = (unsigned*)(args.ws + WS_CTL) + CW_BAR; bar.x = 0; bar.st = nullptr;
    if (MK_ONE_LAUNCH) bar = xcd_barrier_post((unsigned*)(args.ws + WS_CTL) + CW_BAR, MISC + 8, wave_s);
    const int lo = args.ph_lo, hi = args.ph_hi;
    int pc = 0;
#ifndef PROBE_DUP
#define PROBE_DUP 0u
#endif
#define PH_BEGIN(id) if (pc >= lo && pc < hi && (PHSEL & (1u << (id)))) for (int rep_ = ((PROBE_DUP & (1u << (id))) ? 1 : 0); rep_ >= 0; --rep_) { __syncthreads(); \
        const __attribute__((address_space(4))) fptr_t* inl = (const __attribute__((address_space(4))) fptr_t*)__builtin_amdgcn_kernarg_segment_ptr(); asm volatile("" : "+s"(inl)); \
        Ctx c; _Pragma("unroll") for (int i_ = 0; i_ < 24; ++i_) c.in[i_] = inl[i_]; c.ws = (unsigned char*)inl[25]; float* const outp = (float*)inl[24]; (void)outp; \
        int tid_ = wave_s * 64 + mk_lane(); asm volatile("" : "+v"(tid_)); int bx_ = blockIdx.x; asm volatile("" : "+s"(bx_)); int G_ = gridDim.x; asm volatile("" : "+s"(G_)); \
        c.lds = lds; c.tid = tid_; c.lane = c.tid & 63; c.wave = __builtin_amdgcn_readfirstlane(c.tid >> 6); \
        c.G = G_; c.bx = bx_; c.vcu = (c.G % 8 == 0) ? (bx_ % 8) * (c.G / 8) + bx_ / 8 : bx_; \
        bf16* const X = (bf16*)(c.ws + WS_X); bf16* const U = (bf16*)(c.ws + WS_U); bf16* const Gb = (bf16*)(c.ws + WS_G); bf16* const HID = (bf16*)(c.ws + WS_HID); \
        float* const TA0 = (float*)(c.ws + WS_TA); float* const TA1 = (float*)(c.ws + WS_TA + SZ_F32ROWS); \
        bf16* const Qb = (bf16*)(c.ws + WS_Q); bf16* const Kb = (bf16*)(c.ws + WS_K); bf16* const Vb = (bf16*)(c.ws + WS_V); bf16* const Ob = (bf16*)(c.ws + WS_O); float* const GATES = (float*)(c.ws + WS_GATES); \
        const int j = layer >> 1; const float* const modl = (const float*)(c.ws + WS_MOD) + (size_t)layer * 5 * 6 * D; \
        const void* const ctxsrc = layer == 0 ? (const void*)c.in[2] : (const void*)X; const void* const latsrc = layer == 0 ? (const void*)c.in[0] : (const void*)(X + (size_t)NRC * D); \
        (void)X; (void)U; (void)Gb; (void)HID; (void)TA0; (void)TA1; (void)Qb; (void)Kb; (void)Vb; (void)Ob; (void)GATES; (void)j; (void)modl; (void)ctxsrc; (void)latsrc;
#ifndef PROBE_XBAR
#define PROBE_XBAR 0
#endif
#define PH_END } if (MK_ONE_LAUNCH && pc >= lo && pc + 1 < hi) { xcd_barrier(bar, wave_s); if (PROBE_XBAR) xcd_barrier(bar, wave_s); } ++pc;

    int layer = 0;
    PH_BEGIN(0) phase_prologue(c); PH_END

    for (layer = 0; layer < DEPTH; ++layer) {
        if ((layer & 1) == 0) {
            PH_BEGIN(1) if (layer == 0) phase_norm<false, true>(c, ctxsrc, latsrc, c.in[6] + layer * D, modl, 0, 1, U, nullptr, X, 0); else phase_norm<false, false>(c, ctxsrc, latsrc, c.in[6] + layer * D, modl, 0, 1, U, rep_ ? nullptr : (const bf16*)TA0, X, 0); PH_END
            PH_BEGIN(2) phase_s5_scan3(c, j, U, (bf16*)TA0, (bf16*)TA1); PH_END
            PH_BEGIN(3) phase_s5_combine(c, c.in[16] + j * D, U, (const bf16*)TA0, (const bf16*)TA1, Gb); PH_END
            PH_BEGIN(4) { pg8::Gemm g{Gb, (const bf16*)(c.ws + WS_WGLU + j * SZ_WGLU), NR, 2 * D, D}; pg8::StaticOrder S; S.init(NR, 2 * D, c.G, c.bx, D);
                EpiGlu E{c.in[2], c.in[0], X, modl, 0, layer == 0}; pg8::gemm_phase<EpiGlu, pg8::StaticOrder, true, true>(c.lds, g, S, E, c.tid);
                if (rep_ == 0) tail_convert(c, (NR / 256) * (2 * D / 256), layer == 0 ? TAIL_GLU0_LO : TAIL_GLU2_LO, layer == 0 ? TAIL_GLU0_HI : TAIL_GLU2_HI); } PH_END
        } else {
            PH_BEGIN(5) phase_norm<true, false>(c, ctxsrc, latsrc, c.in[6] + layer * D, modl, 0, 1, U, rep_ ? nullptr : (const bf16*)TA0, X, 0); PH_END
            PH_BEGIN(6) { pg8::Gemm g{U, (const bf16*)(c.ws + WS_WMLI + j * SZ_WMLI), NR, MLINP, D}; pg8::StaticOrder S; S.init(NR, MLINP, c.G, c.bx, D);
                EpiMli E{Qb, Kb, Vb, Ob, GATES, c.in[19] + j * 32}; pg8::gemm_phase<EpiMli, pg8::StaticOrder, true, true>(c.lds, g, S, E, c.tid);
                if (rep_ == 0 && layer == 1) tail_convert(c, (NR / 256) * (MLINP / 256), TAIL_MLI1_LO, TAIL_MLI1_HI); } PH_END
            PH_BEGIN(7) phase_mlstm_chunk2(c, Qb, Kb, Vb, GATES, (bf16*)TA0, (bf16*)TA1); PH_END
            PH_BEGIN(8) phase_ml_readout(c, (const bf16*)TA0, (const bf16*)TA1, Ob, c.in[20] + j * D, Gb, layer == 3 ? NRC : 0); PH_END
            PH_BEGIN(9) { pg8::Gemm g{Gb, (const bf16*)(c.ws + WS_WMLO + j * SZ_WMLO), NR, D, D}; ResCtxOrder S; S.init(c.G, c.bx, D, layer == 1, 4, 8);
                EpiResSlab E{X, (bf16*)TA0, modl, 2}; pg8::gemm_phase<EpiResSlab, ResCtxOrder, true, true>(c.lds, g, S, E, c.tid); } PH_END
        }
        PH_BEGIN(10) phase_norm<false, false>(c, X, X + (size_t)NRC * D, c.in[7] + layer * D, modl, 3, 4, U, (layer == 1 && rep_ == 0) ? (const bf16*)TA0 : nullptr, X, layer == 3 ? NRC : 0); PH_END
        PH_BEGIN(11) { const int pm0 = layer == 3 ? 4 : 0; pg8::Gemm g{U + (size_t)pm0 * 256 * D, (const bf16*)(c.ws + WS_WFFI + layer * SZ_WFFI), NR - pm0 * 256, 2 * FF, D}; pg8::StaticOrder S; S.init(NR - pm0 * 256, 2 * FF, c.G, c.bx, D);
            EpiFfi E{HID, pm0}; pg8::gemm_phase<EpiFfi, pg8::StaticOrder, true, true>(c.lds, g, S, E, c.tid);
            if (rep_ == 0 && layer < 3) tail_convert(c, (NR / 256) * (2 * FF / 256), layer == 0 ? TAIL_FFI0_LO : (layer == 1 ? TAIL_FFI1_LO : TAIL_FFI2_LO), layer == 0 ? TAIL_FFI0_HI : (layer == 1 ? TAIL_FFI1_HI : TAIL_FFI2_HI)); } PH_END
        PH_BEGIN(12) { pg8::Gemm g{HID, (const bf16*)(c.ws + WS_WFFO + layer * SZ_WFFO), NR, D, FF}; ResCtxOrder S; S.init(c.G, c.bx, FF, layer < 3, 12, 4);
            EpiResSlab E{X, (bf16*)TA0, modl, 5}; pg8::gemm_phase<EpiResSlab, ResCtxOrder, true, true>(c.lds, g, S, E, c.tid); } PH_END
    }
    layer = 0;
    PH_BEGIN(13) phase_final(c, X, c.in[8], outp); PH_END
#undef PH_BEGIN
#undef PH_END
}

extern "C" void kernel_launch(void* const* d_in, const int* in_sizes, int n_in, void* d_out, int out_size, void* d_ws, size_t ws_size, hipStream_t stream) {
    static int grid = 0;
    if (grid == 0) {
        if (n_in != 24 || in_sizes[0] != NRL * D || out_size != NRL * D || ws_size < WS_END) { fprintf(stderr, "kernel_launch: unexpected shapes (n_in %d, in0 %d, out %d, ws %zu < %zu); nothing launched\n", n_in, n_in > 0 ? in_sizes[0] : -1, out_size, ws_size, (size_t)WS_END); grid = -1; return; }
        int dev = 0, cus = 0, per_cu = 0;
        if (hipGetDevice(&dev) != hipSuccess || hipDeviceGetAttribute(&cus, hipDeviceAttributeMultiprocessorCount, dev) != hipSuccess) { grid = -1; return; }
        if (hipFuncSetAttribute((const void*)mk_fwd, hipFuncAttributeMaxDynamicSharedMemorySize, LDS_BYTES) != hipSuccess) { fprintf(stderr, "kernel_launch: hipFuncSetAttribute failed\n"); grid = -1; return; }
        if (hipOccupancyMaxActiveBlocksPerMultiprocessor(&per_cu, (const void*)mk_fwd, NWAVES * 64, LDS_BYTES) != hipSuccess || per_cu < 1)
            fprintf(stderr, "kernel_launch: occupancy query reports %d workgroups per CU\n", per_cu);
        (void)hipGetLastError();
        grid = cus;
    }
    if (grid < 0) return;
    if (hipMemsetAsync((char*)d_ws + WS_CTL, 0, CTL_ZERO_BYTES, stream) != hipSuccess) return;
    Args a{};
    for (int i = 0; i < 24; ++i) a.in[i] = (const float*)d_in[i];
    a.out = (float*)d_out; a.ws = (unsigned char*)d_ws;
#if MK_ONE_LAUNCH
    a.ph_lo = 0; a.ph_hi = NPHASES;
    hipLaunchKernelGGL(mk_fwd, dim3(grid), dim3(NWAVES * 64), LDS_BYTES, stream, a);
#else
    for (int ph = 0; ph < NPHASES; ++ph) { a.ph_lo = ph; a.ph_hi = ph + 1; hipLaunchKernelGGL(mk_fwd, dim3(grid), dim3(NWAVES * 64), LDS_BYTES, stream, a); }
#endif
}
```

```cpp
#include <hip/hip_runtime.h>
#include <cstdio>
namespace pg8 {
#define PG8_LAS __attribute__((address_space(3)))
typedef unsigned short bf16_t;
typedef short bf16x8 __attribute__((ext_vector_type(8)));
typedef float f32x4 __attribute__((ext_vector_type(4)));
typedef unsigned u32x4 __attribute__((ext_vector_type(4)));
constexpr int BM = 256, BK = 64, HALF = 128, HTB = HALF * BK * 2  , STAGE_BYTES = 8 * HTB, NXCD = 8, WGM = 4;

__host__ __device__ __forceinline__ int lds_byte(int r, int c) { const int st = (r >> 4) * 2 + (c >> 5), rr = r & 15, cc = c & 31, ob = rr * 64 + cc * 2; return st * 1024 + (ob ^ (((ob >> 9) & 1) << 5)); }
__host__ __device__ __forceinline__ void stage_rc(int b, int& R, int& C) { const int st = b / 1024, sb = b % 1024, swz = sb ^ (((sb >> 9) & 1) << 5); R = (st >> 1) * 16 + swz / 64; C = (st & 1) * 32 + (swz % 64) / 2; }
__host__ __device__ __forceinline__ int perm32(int rho) { const int n = rho >> 4, i = rho & 15; return 8 * (i >> 2) + 4 * n + (i & 3); }

struct Unit { int pm, pn, k0, nt, ks; };
struct Gemm { const bf16_t* A; const bf16_t* Bt; int M, N, K; };

struct StaticOrder {
    int nM, nN, nwg, G, c, ntile;
    __host__ __device__ void init(int M, int N, int G_, int c_, int K_) { nM = M / BM; nN = N / BM; nwg = nM * nN; G = G_; c = c_; ntile = K_ / BK; }
    __host__ __device__ bool next(int i, Unit& u) const {
        const long L = (long)i * G + c; if (L >= nwg) return false;
        int wgid = (int)L; { const int q = nwg / NXCD, r = nwg % NXCD, xcd = wgid % NXCD, off = wgid / NXCD; wgid = (xcd < r ? xcd * (q + 1) : r * (q + 1) + (xcd - r) * q) + off; }
        const int nig = WGM * nN, gid = wgid / nig, fm = gid * WGM, gsz = (nM - fm) < WGM ? (nM - fm) : WGM;
        u.pm = fm + ((wgid % nig) % gsz); u.pn = (wgid % nig) / gsz; u.k0 = 0; u.nt = ntile; u.ks = 0; return true;
    }
    __device__ __forceinline__ void a_ready(const Unit&) const {}
    __device__ __forceinline__ void done(const Unit&) const {}
};

typedef __bf16 bf16v2_t __attribute__((ext_vector_type(2))); typedef float f32v2_t __attribute__((ext_vector_type(2)));
__device__ __forceinline__ unsigned cvt_pk_bf16(float lo, float hi) { const f32v2_t v = {lo, hi}; return __builtin_bit_cast(unsigned, __builtin_convertvector(v, bf16v2_t)); }
template <class Epi, class Sched, bool ALIGN_EPI = false, bool SP2 = false>
__device__ __forceinline__ void gemm_phase(PG8_LAS unsigned char* lds, const Gemm g, const Sched& S, const Epi& E, int tid_in) {
    int tid_l = tid_in; asm volatile("" : "+v"(tid_l));
    const int tid = tid_l, wid = __builtin_amdgcn_readfirstlane(tid >> 6), lane = tid & 63, wr = wid >> 2, wc = wid & 3, fr = lane & 15, fq = lane >> 4;
    const int K = g.K;
    unsigned voffA[2], voffB[2];
#pragma unroll
    for (int i = 0; i < 2; ++i) { int R, C; stage_rc(tid * 16 + i * 8192, R, C); const int Rb = Epi::PERM ? ((R & ~31) + perm32(R & 31)) : R;
        voffA[i] = (unsigned)(R * K + C) * 2u; voffB[i] = (unsigned)(Rb * K + C) * 2u; }
    const size_t kstep = (size_t)(BK * 2);
    const size_t hstep = (size_t)HALF * K * 2;
    const size_t tstep = 2 * hstep;
    const unsigned ldsw = (unsigned)wid * 1024u;
    const int aoff = lds_byte(wr * 64 + fr, fq * 8), boff = lds_byte(wc * 32 + fr, fq * 8);
#define PG8_SA(b, h) (((b) * 2 + (h)) * HTB)
#define PG8_SB(b, h) ((4 + (b) * 2 + (h)) * HTB)
#define PG8_STAGE(bufoff, gbase, voff) do { _Pragma("unroll") for (int _i = 0; _i < 2; ++_i) \
        __builtin_amdgcn_global_load_lds((const unsigned*)((const char*)(gbase) + (voff)[_i]), (PG8_LAS unsigned*)(lds + (bufoff) + ldsw + _i * 8192), 16, 0, 0); } while (0)
#define PG8_LDA(dst, b, h) do { _Pragma("unroll") for (int m = 0; m < 4; ++m) _Pragma("unroll") for (int k = 0; k < 2; ++k) dst[m][k] = *(const PG8_LAS bf16x8*)(lds + PG8_SA(b, h) + aoff + m * 2048 + k * 1024); } while (0)
#define PG8_LDB(dst, b, h) do { _Pragma("unroll") for (int n = 0; n < 2; ++n) _Pragma("unroll") for (int k = 0; k < 2; ++k) dst[n][k] = *(const PG8_LAS bf16x8*)(lds + PG8_SB(b, h) + boff + n * 2048 + k * 1024); } while (0)
#define PG8_MMA(ai, bj, At, Bt) do { __builtin_amdgcn_s_setprio(1); _Pragma("unroll") for (int m = 0; m < 4; ++m) _Pragma("unroll") for (int n = 0; n < 2; ++n) _Pragma("unroll") for (int k = 0; k < 2; ++k) \
        acc[ai][bj][m][n] = __builtin_amdgcn_mfma_f32_16x16x32_bf16(Bt[n][k], At[m][k], acc[ai][bj][m][n], 0, 0, 0); __builtin_amdgcn_s_setprio(0); } while (0)
#define PG8_WAIT_V(n) asm volatile("s_waitcnt vmcnt(" #n ")" ::: "memory")
#define PG8_WAIT_L(n) asm volatile("s_waitcnt lgkmcnt(" #n ")" ::: "memory")
#define PG8_WAIT_V8R(relax) asm volatile("s_cmp_eq_u32 %0, 0\n\ts_cbranch_scc1 1f\n\ts_waitcnt vmcnt(%1)\n\ts_branch 2f\n1:\n\ts_waitcnt vmcnt(8)\n2:" :: "s"(relax), "i"(8 + Epi::NOPS) : "memory", "scc")
#define PG8_BAR __builtin_amdgcn_s_barrier()
#define PG8_SCHED __builtin_amdgcn_sched_barrier(0)
    Unit cur, nxt; int ui = 0;
    if (!S.next(0, cur)) return;
    f32x4 acc[2][2][4][2];
#pragma unroll
    for (int a = 0; a < 2; ++a)
#pragma unroll
        for (int b = 0; b < 2; ++b)
#pragma unroll
            for (int m = 0; m < 4; ++m)
#pragma unroll
                for (int n = 0; n < 2; ++n) acc[a][b][m][n] = (f32x4){0.f, 0.f, 0.f, 0.f};
    bf16x8 At[4][2], B0[2][2], B1[2][2];
    const char* cA = (const char*)g.A + (size_t)cur.pm * tstep + (size_t)cur.k0 * 2; const char* cB = (const char*)g.Bt + (size_t)cur.pn * tstep + (size_t)cur.k0 * 2;
    S.a_ready(cur);
    if constexpr (SP2) {
        PG8_STAGE(PG8_SB(0, 0), cB, voffB); PG8_STAGE(PG8_SB(0, 1), cB + hstep, voffB); PG8_STAGE(PG8_SA(0, 0), cA, voffA); PG8_STAGE(PG8_SA(0, 1), cA + hstep, voffA);
        PG8_STAGE(PG8_SB(1, 0), cB + kstep, voffB); PG8_STAGE(PG8_SA(1, 0), cA + kstep, voffA); PG8_STAGE(PG8_SB(1, 1), cB + hstep + kstep, voffB);
        if (wr == 1) PG8_BAR;
        PG8_WAIT_V(6); PG8_BAR;
        PG8_BAR;
    } else {
        PG8_STAGE(PG8_SB(0, 0), cB, voffB); PG8_STAGE(PG8_SA(0, 0), cA, voffA); PG8_STAGE(PG8_SB(0, 1), cB + hstep, voffB); PG8_STAGE(PG8_SA(0, 1), cA + hstep, voffA);
        if (wr == 1) PG8_BAR;
        PG8_WAIT_V(4); PG8_BAR;
        PG8_STAGE(PG8_SB(1, 0), cB + kstep, voffB); PG8_STAGE(PG8_SA(1, 0), cA + kstep, voffA); PG8_STAGE(PG8_SB(1, 1), cB + hstep + kstep, voffB);
        PG8_WAIT_V(6); PG8_BAR;
    }
    for (;;) {
        const bool has_next = S.next(ui + 1, nxt);
        const char* nA = has_next ? (const char*)g.A + (size_t)nxt.pm * tstep + (size_t)nxt.k0 * 2 : cA; const char* nB = has_next ? (const char*)g.Bt + (size_t)nxt.pn * tstep + (size_t)nxt.k0 * 2 : cB;
        const int nt = cur.nt;
        for (int t = 0; t < nt; t += 2) {
            const bool last = (t == nt - 2);
            const char* a1 = cA + (size_t)(t + 1) * kstep;
            const char* a2 = last ? nA : cA + (size_t)(t + 2) * kstep; const char* b2 = last ? nB : cB + (size_t)(t + 2) * kstep;
            const char* a3 = a2 + kstep; const char* b3 = b2 + kstep;
            if (last && has_next) S.a_ready(nxt);
            if constexpr (SP2) {
            PG8_LDB(B0, 0, 0); PG8_LDB(B1, 0, 1); PG8_SCHED; PG8_LDA(At, 0, 0); PG8_STAGE(PG8_SA(1, 1), a1 + hstep, voffA);
            PG8_WAIT_V(8); PG8_WAIT_L(0); PG8_BAR; PG8_MMA(0, 0, At, B0); PG8_MMA(0, 1, At, B1); PG8_BAR; PG8_SCHED;
            PG8_LDA(At, 0, 1); PG8_STAGE(PG8_SB(0, 0), b2, voffB); PG8_STAGE(PG8_SB(0, 1), b2 + hstep, voffB); PG8_STAGE(PG8_SA(0, 0), a2, voffA);
            PG8_WAIT_V(8); PG8_WAIT_L(0); PG8_BAR; PG8_MMA(1, 0, At, B0); PG8_MMA(1, 1, At, B1); PG8_BAR; PG8_SCHED;
            PG8_LDB(B0, 1, 0); PG8_LDB(B1, 1, 1); PG8_SCHED; PG8_LDA(At, 1, 0); PG8_STAGE(PG8_SA(0, 1), a2 + hstep, voffA);
            PG8_WAIT_V(8); PG8_WAIT_L(0); PG8_BAR; PG8_MMA(0, 0, At, B0); PG8_MMA(0, 1, At, B1); PG8_BAR; PG8_SCHED;
            PG8_LDA(At, 1, 1); PG8_STAGE(PG8_SB(1, 0), b3, voffB); PG8_STAGE(PG8_SB(1, 1), b3 + hstep, voffB); PG8_STAGE(PG8_SA(1, 0), a3, voffA);
            PG8_WAIT_V(8); PG8_WAIT_L(0); PG8_BAR; PG8_MMA(1, 0, At, B0); PG8_MMA(1, 1, At, B1); PG8_BAR; PG8_SCHED;
            } else {
            PG8_LDB(B0, 0, 0); PG8_SCHED; PG8_LDA(At, 0, 0); PG8_STAGE(PG8_SA(1, 1), a1 + hstep, voffA);
            PG8_WAIT_L(8); PG8_BAR; PG8_WAIT_L(0); PG8_MMA(0, 0, At, B0); PG8_BAR; PG8_SCHED;
            PG8_LDB(B1, 0, 1); PG8_STAGE(PG8_SB(0, 0), b2, voffB);
            PG8_BAR; PG8_WAIT_L(0); PG8_MMA(0, 1, At, B1); PG8_BAR;
            PG8_LDA(At, 0, 1); PG8_STAGE(PG8_SA(0, 0), a2, voffA);
            PG8_BAR; PG8_WAIT_L(0); PG8_MMA(1, 0, At, B0); PG8_BAR; PG8_SCHED;
            PG8_STAGE(PG8_SB(0, 1), b2 + hstep, voffB);
            PG8_WAIT_V(6); PG8_BAR; PG8_MMA(1, 1, At, B1); PG8_BAR;
            PG8_LDB(B0, 1, 0); PG8_SCHED; PG8_LDA(At, 1, 0); PG8_STAGE(PG8_SA(0, 1), a2 + hstep, voffA);
            PG8_WAIT_L(8); PG8_BAR; PG8_WAIT_L(0); PG8_MMA(0, 0, At, B0); PG8_BAR; PG8_SCHED;
            PG8_LDB(B1, 1, 1); PG8_STAGE(PG8_SB(1, 0), b3, voffB);
            PG8_BAR; PG8_WAIT_L(0); PG8_MMA(0, 1, At, B1); PG8_BAR;
            PG8_LDA(At, 1, 1); PG8_STAGE(PG8_SA(1, 0), a3, voffA);
            PG8_BAR; PG8_WAIT_L(0); PG8_MMA(1, 0, At, B0); PG8_BAR; PG8_SCHED;
            PG8_STAGE(PG8_SB(1, 1), b3 + hstep, voffB);
            PG8_WAIT_V(6); PG8_BAR; PG8_MMA(1, 1, At, B1); PG8_BAR;
            }
        }
        if constexpr (ALIGN_EPI) { if (wr == 0) PG8_BAR; }
        if constexpr (!Epi::AFTER_DRAIN) { E(acc, cur, wr, wc, fr, fq);
#if defined(PROBE_EPI2)
            if constexpr (Epi::PERM) { asm volatile("" ::: "memory"); E(acc, cur, wr, wc, fr, fq); }
#endif
            S.done(cur); }
        if (!has_next) break;
#pragma unroll
        for (int a = 0; a < 2; ++a)
#pragma unroll
            for (int b = 0; b < 2; ++b)
#pragma unroll
                for (int m = 0; m < 4; ++m)
#pragma unroll
                    for (int n = 0; n < 2; ++n) acc[a][b][m][n] = (f32x4){0.f, 0.f, 0.f, 0.f};
        cur = nxt; cA = nA; cB = nB; ++ui;
        if constexpr (ALIGN_EPI) { if (wr == 1) PG8_BAR; }
    }
    PG8_WAIT_V(0);
    if constexpr (!ALIGN_EPI) { if (wr == 0) PG8_BAR; }
    PG8_BAR;
    if constexpr (Epi::AFTER_DRAIN) { E.fused(acc, cur, wr, wc, fr, fq, lds, wid, lane); S.done(cur); }
#undef PG8_SA
#undef PG8_SB
#undef PG8_STAGE
#undef PG8_LDA
#undef PG8_LDB
#undef PG8_MMA
#undef PG8_WAIT_V
#undef PG8_WAIT_L
#undef PG8_WAIT_V8R
#undef PG8_BAR
#undef PG8_SCHED
}
}

#ifndef MK_ONE_LAUNCH
#define MK_ONE_LAUNCH 1
#endif
constexpr int D = 2048, NBATCH = 4, SEQ = 4096, CTXL = 256, DEPTH = 4;
constexpr int NRC = NBATCH * CTXL, NRL = NBATCH * SEQ, NR = NRC + NRL;
constexpr int FF = 5632, MLIN = 6176, MLINP = 6400;
constexpr int NHEAD = 8, DV = 256, DQK = 128;
constexpr float EPSN = 1e-6f;
constexpr int NWAVES = 8;

constexpr size_t MiB = 1u << 20;
constexpr size_t WS_CTL = 0, CTL_ZERO_BYTES = 128 * 1024;
constexpr size_t WS_MOD = 1 * MiB;
constexpr size_t WS_WFFI = 2 * MiB,   SZ_WFFI = (size_t)2 * FF * D * 2;
constexpr size_t WS_WFFO = 178 * MiB, SZ_WFFO = (size_t)D * FF * 2;
constexpr size_t WS_WGLU = 266 * MiB, SZ_WGLU = (size_t)2 * D * D * 2;
constexpr size_t WS_WMLI = 298 * MiB, SZ_WMLI = (size_t)MLINP * D * 2;
constexpr size_t WS_WMLO = 348 * MiB, SZ_WMLO = (size_t)D * D * 2;
constexpr size_t WS_X = 364 * MiB;
constexpr size_t WS_U = 500 * MiB;
constexpr size_t WS_G = 568 * MiB;
constexpr size_t WS_HID = 636 * MiB;
constexpr size_t WS_TA = 823 * MiB, SZ_F32ROWS = (size_t)NR * D * 4;
constexpr size_t WS_Q = 1095 * MiB, WS_K = 1129 * MiB, WS_V = 1163 * MiB, WS_O = 1231 * MiB, WS_GATES = 1299 * MiB;
constexpr size_t WS_END = 1302 * MiB;
static_assert(WS_WFFI + 4 * SZ_WFFI <= WS_WFFO && WS_WFFO + 4 * SZ_WFFO <= WS_WGLU && WS_WGLU + 2 * SZ_WGLU <= WS_WMLI && WS_WMLI + 2 * SZ_WMLI <= WS_WMLO && WS_WMLO + 2 * SZ_WMLO <= WS_X, "ws map 1");
static_assert(WS_X + SZ_F32ROWS <= WS_U && WS_U + (size_t)NR * D * 2 <= WS_G && WS_G + (size_t)NR * D * 2 <= WS_HID && WS_HID + (size_t)NR * FF * 2 <= WS_TA && WS_TA + 2 * SZ_F32ROWS <= WS_Q, "ws map 2");
static_assert(WS_Q + (size_t)NR * 1024 * 2 <= WS_K && WS_K + (size_t)NR * 1024 * 2 <= WS_V && WS_V + (size_t)NR * D * 2 <= WS_O && WS_O + (size_t)NR * D * 2 <= WS_GATES && WS_GATES + (size_t)NR * 32 * 4 <= WS_END, "ws map 3");
constexpr int CW_S5F = 16384;
constexpr int CW_BAR = 4096;

constexpr int RING_BYTES = 131072, LDSCTL_OFF = RING_BYTES, MISC_OFF = LDSCTL_OFF + 320, LDS_BYTES = 147456;

#define GAS __attribute__((address_space(1)))
#define LAS __attribute__((address_space(3)))
typedef unsigned short bf16;
typedef unsigned v4u __attribute__((ext_vector_type(4)));
typedef unsigned v2u __attribute__((ext_vector_type(2)));
typedef float f32x4 __attribute__((ext_vector_type(4)));
typedef short bf16x8 __attribute__((ext_vector_type(8)));

__device__ __forceinline__ unsigned f2bf(float f) { unsigned u = __builtin_bit_cast(unsigned, f); return (u + 0x7fffu + ((u >> 16) & 1u)) >> 16; }
__device__ __forceinline__ unsigned pk2(float lo, float hi) { return pg8::cvt_pk_bf16(lo, hi); }
__device__ __forceinline__ float bflo(unsigned w) { return __builtin_bit_cast(float, w << 16); }
__device__ __forceinline__ float bfhi(unsigned w) { return __builtin_bit_cast(float, w & 0xffff0000u); }
__device__ __forceinline__ size_t xblk(int R, int col) { return ((size_t)((R >> 8) * 8 + (col >> 8)) << 16) + (size_t)(((R & 255) << 8) + (col & 255)); }
__device__ __forceinline__ float bf2f(bf16 b) { return __builtin_bit_cast(float, ((unsigned)b) << 16); }
__device__ __forceinline__ float fsigmoid(float x) { return __builtin_amdgcn_rcpf(1.0f + __builtin_amdgcn_exp2f(-1.4426950408889634f * x)); }
#define WS_DPP(src, ctrl, rmask) __builtin_bit_cast(float, __builtin_amdgcn_update_dpp(0, __builtin_bit_cast(int, (float)(src)), (ctrl), (rmask), 0xf, false))
__device__ __forceinline__ float wave_sum(float v) {
    v += WS_DPP(v, 0xB1, 0xf); v += WS_DPP(v, 0x4E, 0xf); v += WS_DPP(v, 0x141, 0xf); v += WS_DPP(v, 0x140, 0xf);
    v += WS_DPP(v, 0x142, 0xa); v += WS_DPP(v, 0x143, 0xc);
    return __builtin_bit_cast(float, __builtin_amdgcn_readlane(__builtin_bit_cast(int, v), 63));
}

#define XB_TMO      128
#define XB_XCNT(j)  (256  + 64 * (j))
#define XB_XSUB(j)  (1280 + 64 * (j))
#define XB_XGEN(j)  (2304 + 64 * (j))
#define XB_TOP      3328
#define XB_TOPGEN   3392
#define XCD_BAR_WORDS 3456
#define XB_SPIN_CAP (1u << 18)
__device__ __forceinline__ unsigned xb_ld(unsigned* p)              { return __hip_atomic_load(p, __ATOMIC_RELAXED, __HIP_MEMORY_SCOPE_AGENT); }
__device__ __forceinline__ unsigned xb_add(unsigned* p, unsigned v) { return __hip_atomic_fetch_add(p, v, __ATOMIC_RELAXED, __HIP_MEMORY_SCOPE_AGENT); }
__device__ __forceinline__ unsigned xb_xcc_id() { return (unsigned)__builtin_amdgcn_s_getreg((3 << 11) | 20) & 0xFu; }
#define XB_SPIN(cond, bar) do { unsigned _sp = 0; while (cond) { __builtin_amdgcn_s_sleep(1); \
    if ((++_sp & 255u) == 0u) { if (xb_ld(&(bar)[XB_TMO])) break; if (_sp > XB_SPIN_CAP) { atomicAdd(&(bar)[XB_TMO], 1u); break; } } } } while (0)
__device__ __forceinline__ int mk_lane() { unsigned m = ~0u; asm volatile("" : "+s"(m)); return (int)__builtin_amdgcn_mbcnt_hi(m, __builtin_amdgcn_mbcnt_lo(m, 0u)); }
struct XcdBarrier { unsigned* bar; unsigned x; volatile LAS unsigned* st; };
__device__ __forceinline__ XcdBarrier xcd_barrier_post(unsigned* bar, volatile LAS unsigned* st, int wave) {
    XcdBarrier b; b.bar = bar; b.x = xb_xcc_id(); b.st = st;
    if (wave == 0 && mk_lane() == 0) (void)xb_add(&bar[XB_XCNT(b.x)], 1u);
    return b;
}
__device__ __forceinline__ void xcd_barrier_complete(unsigned* bar, unsigned x, unsigned& nloc, unsigned& nx) {
    const unsigned G = gridDim.x * gridDim.y * gridDim.z;
    unsigned sum, cnt, mine, sp = 0u;
    for (;;) {
        sum = 0u; cnt = 0u; mine = 0u;
#pragma unroll
        for (unsigned j = 0; j < 16; ++j) { const unsigned c = xb_ld(&bar[XB_XCNT(j)]); sum += c; cnt += (c > 0u) ? 1u : 0u; mine = (j == x) ? c : mine; }
        if (sum == G) break;
        __builtin_amdgcn_s_sleep(1);
        if ((++sp & 255u) == 0u) { if (xb_ld(&bar[XB_TMO])) break; if (sp > XB_SPIN_CAP) { atomicAdd(&bar[XB_TMO], 1u); break; } }
    }
    nloc = mine > 0u ? mine : 1u; nx = cnt > 0u ? cnt : 1u;
}
__device__ __forceinline__ void xcd_barrier(const XcdBarrier& b, int wave) {
    asm volatile("s_waitcnt vmcnt(0)" ::: "memory");
    __syncthreads();
    if (wave == 0 && mk_lane() == 0) {
        unsigned* bar = b.bar;
        __builtin_amdgcn_s_waitcnt(0);
        unsigned nloc = b.st[0], nx = b.st[1];
        if (nloc == 0u) { xcd_barrier_complete(bar, b.x, nloc, nx); b.st[0] = nloc; b.st[1] = nx; }
        const unsigned old = xb_add(&bar[XB_XSUB(b.x)], 1u);
        const unsigned gen = old / nloc;
        if (old + 1u == (gen + 1u) * nloc) {
            __builtin_amdgcn_fence(__ATOMIC_RELEASE, "agent");
            asm volatile("s_waitcnt vmcnt(0)" ::: "memory");
            const unsigned og = xb_add(&bar[XB_TOP], 1u);
            const unsigned tg = og / nx;
            if (og + 1u == (tg + 1u) * nx) xb_add(&bar[XB_TOPGEN], 1u);
            else XB_SPIN(xb_ld(&bar[XB_TOPGEN]) == tg, bar);
            __builtin_amdgcn_fence(__ATOMIC_ACQUIRE, "agent");
            xb_add(&bar[XB_XGEN(b.x)], 1u);
            asm volatile("s_waitcnt vmcnt(0)" ::: "memory");
        } else {
            XB_SPIN(xb_ld(&bar[XB_XGEN(b.x)]) == gen, bar);
            __builtin_amdgcn_fence(__ATOMIC_ACQUIRE, "agent");
            asm volatile("s_waitcnt vmcnt(0)" ::: "memory");
        }
    }
    __syncthreads();
}

__device__ __forceinline__ int row_r(int pm) { return pm < 4 ? 4 : ((pm - 4) >> 4); }

struct EpiGlu {
    static constexpr bool PERM = true, AFTER_DRAIN = false;
    static constexpr int NOPS = 18;
    const float* b32ctx; const float* b32lat; bf16* X; const float* mod; int pm0; int src32;
    __device__ __forceinline__ void operator()(const pg8::f32x4 (&acc)[2][2][4][2], const pg8::Unit& u, int wr, int wc, int fr, int fq) const {
        const int pmg = u.pm + pm0; const int r = row_r(pmg); const int j0 = u.pn * 128 + wc * 32 + 8 * fq;
        const float* gp = mod + (size_t)(r * 6 + 2) * D + j0;
        const f32x4 g0 = *(const f32x4*)gp, g1 = *(const f32x4*)(gp + 4);
        if (src32) {
            f32x4 bs[2][4][2];
#pragma unroll
            for (int ai = 0; ai < 2; ++ai)
#pragma unroll
                for (int m = 0; m < 4; ++m) {
                    const int R = pmg * 256 + ai * 128 + wr * 64 + m * 16 + fr;
                    const float* bp = (R < NRC ? b32ctx + (size_t)R * D : b32lat + (size_t)(R - NRC) * D) + j0;
#pragma unroll
                    for (int n = 0; n < 2; ++n) bs[ai][m][n] = __builtin_nontemporal_load((const f32x4*)(bp + 4 * n)); }
            asm volatile("" ::: "memory");
#pragma unroll
            for (int ai = 0; ai < 2; ++ai)
#pragma unroll
                for (int m = 0; m < 4; ++m) {
                    const int R = pmg * 256 + ai * 128 + wr * 64 + m * 16 + fr;
                    float o[8];
#pragma unroll
                    for (int n = 0; n < 2; ++n) {
                        const f32x4 a = acc[ai][0][m][n], b = acc[ai][1][m][n]; const f32x4 gv = n ? g1 : g0;
#pragma unroll
                        for (int e = 0; e < 4; ++e) o[4 * n + e] = bs[ai][m][n][e] + gv[e] * (a[e] * __builtin_amdgcn_rcpf(1.0f + __builtin_amdgcn_exp2f(b[e]))); }
                    v4u w; w.x = pg8::cvt_pk_bf16(o[0], o[1]); w.y = pg8::cvt_pk_bf16(o[2], o[3]); w.z = pg8::cvt_pk_bf16(o[4], o[5]); w.w = pg8::cvt_pk_bf16(o[6], o[7]);
                    *(v4u*)(X + xblk(R, j0)) = w; }
        } else {
            v4u bs[2][4];
#pragma unroll
            for (int ai = 0; ai < 2; ++ai)
#pragma unroll
                for (int m = 0; m < 4; ++m) { const int R = pmg * 256 + ai * 128 + wr * 64 + m * 16 + fr; bs[ai][m] = *(const v4u*)(X + xblk(R, j0)); }
            asm volatile("" ::: "memory");
#pragma unroll
            for (int ai = 0; ai < 2; ++ai)
#pragma unroll
                for (int m = 0; m < 4; ++m) {
                    const int R = pmg * 256 + ai * 128 + wr * 64 + m * 16 + fr;
                    const v4u bw = bs[ai][m]; const float bv[8] = {bflo(bw.x), bfhi(bw.x), bflo(bw.y), bfhi(bw.y), bflo(bw.z), bfhi(bw.z), bflo(bw.w), bfhi(bw.w)};
                    float o[8];
#pragma unroll
                    for (int n = 0; n < 2; ++n) {
                        const f32x4 a = acc[ai][0][m][n], b = acc[ai][1][m][n]; const f32x4 gv = n ? g1 : g0;
#pragma unroll
                        for (int e = 0; e < 4; ++e) o[4 * n + e] = bv[4 * n + e] + gv[e] * (a[e] * __builtin_amdgcn_rcpf(1.0f + __builtin_amdgcn_exp2f(b[e]))); }
                    v4u w; w.x = pg8::cvt_pk_bf16(o[0], o[1]); w.y = pg8::cvt_pk_bf16(o[2], o[3]); w.z = pg8::cvt_pk_bf16(o[4], o[5]); w.w = pg8::cvt_pk_bf16(o[6], o[7]);
                    *(v4u*)(X + xblk(R, j0)) = w; }
        }
    }
};
struct EpiFfi {
    static constexpr bool PERM = true, AFTER_DRAIN = false;
    bf16* H; int pm0;
    static constexpr int NOPS = 8;
    __device__ __forceinline__ void operator()(const pg8::f32x4 (&acc)[2][2][4][2], const pg8::Unit& u, int wr, int wc, int fr, int fq) const {
        const int j0 = u.pn * 128 + wc * 32 + 8 * fq;
#pragma unroll
        for (int ai = 0; ai < 2; ++ai)
#pragma unroll
            for (int m = 0; m < 4; ++m) {
                const int R = (u.pm + pm0) * 256 + ai * 128 + wr * 64 + m * 16 + fr;
                float h[8];
#pragma unroll
                for (int n = 0; n < 2; ++n)
#pragma unroll
                    for (int e = 0; e < 4; ++e) { const float g = acc[ai][0][m][n][e], up = acc[ai][1][m][n][e]; h[4 * n + e] = (g * up) * __builtin_amdgcn_rcpf(1.0f + __builtin_amdgcn_exp2f(-g)); }
                v4u w; w.x = pg8::cvt_pk_bf16(h[0], h[1]); w.y = pg8::cvt_pk_bf16(h[2], h[3]); w.z = pg8::cvt_pk_bf16(h[4], h[5]); w.w = pg8::cvt_pk_bf16(h[6], h[7]);
                *(v4u*)(H + (size_t)R * FF + j0) = w; }
    }
};
template <bool MLPERM> struct EpiRes {
    static constexpr bool PERM = true, AFTER_DRAIN = false;
    bf16* X; const float* mod; int gidx; int pm0;
    static constexpr int NOPS = 16;
    __device__ __forceinline__ void operator()(const pg8::f32x4 (&acc)[2][2][4][2], const pg8::Unit& u, int wr, int wc, int fr, int fq) const {
        const int pmg = u.pm + pm0; const int r = row_r(pmg); const int c0 = u.pn * 256 + wc * 32 + 8 * fq;
        const float* gp = mod + (size_t)(r * 6 + gidx) * D + c0;
        f32x4 gv[2][2];
#pragma unroll
        for (int bj = 0; bj < 2; ++bj)
#pragma unroll
            for (int n = 0; n < 2; ++n) gv[bj][n] = *(const f32x4*)(gp + bj * 128 + n * 4);
        v4u bs[2][4][2];
#pragma unroll
        for (int ai = 0; ai < 2; ++ai)
#pragma unroll
            for (int m = 0; m < 4; ++m) {
                int R = pmg * 256 + ai * 128 + wr * 64 + m * 16 + fr;
                if (MLPERM && R >= NRC) { const int q = R - NRC, p = q & 4095; R = NRC + (q & ~4095) + ((p & 63) << 6) + (p >> 6); }
                const bf16* xp = X + (size_t)R * D + c0;
#pragma unroll
                for (int bj = 0; bj < 2; ++bj) bs[ai][m][bj] = *(const v4u*)(xp + bj * 128); }
        asm volatile("" ::: "memory");
#pragma unroll
        for (int ai = 0; ai < 2; ++ai)
#pragma unroll
            for (int m = 0; m < 4; ++m) {
                int R = pmg * 256 + ai * 128 + wr * 64 + m * 16 + fr;
                if (MLPERM && R >= NRC) { const int q = R - NRC, p = q & 4095; R = NRC + (q & ~4095) + ((p & 63) << 6) + (p >> 6); }
                bf16* xp = X + (size_t)R * D + c0;
#pragma unroll
                for (int bj = 0; bj < 2; ++bj) {
                    const v4u bw = bs[ai][m][bj]; const f32x4 a0 = acc[ai][bj][m][0], a1 = acc[ai][bj][m][1], ga = gv[bj][0], gb = gv[bj][1];
                    v4u w; w.x = pg8::cvt_pk_bf16(bflo(bw.x) + ga[0] * a0[0], bfhi(bw.x) + ga[1] * a0[1]); w.y = pg8::cvt_pk_bf16(bflo(bw.y) + ga[2] * a0[2], bfhi(bw.y) + ga[3] * a0[3]);
                    w.z = pg8::cvt_pk_bf16(bflo(bw.z) + gb[0] * a1[0], bfhi(bw.z) + gb[1] * a1[1]); w.w = pg8::cvt_pk_bf16(bflo(bw.w) + gb[2] * a1[2], bfhi(bw.w) + gb[3] * a1[3]);
                    *(v4u*)(xp + bj * 128) = w; } }
    }
};
struct EpiSlab {
    static constexpr bool PERM = true, AFTER_DRAIN = false;
    bf16* slab; const float* mod; int gidx;
    static constexpr int NOPS = 12;
    __device__ __forceinline__ void operator()(const pg8::f32x4 (&acc)[2][2][4][2], const pg8::Unit& u, int wr, int wc, int fr, int fq) const {
        const int c0 = u.pn * 256 + wc * 32 + 8 * fq;
        const float* gp = mod + (size_t)(4 * 6 + gidx) * D + c0;
        f32x4 gv[2][2];
#pragma unroll
        for (int bj = 0; bj < 2; ++bj)
#pragma unroll
            for (int n = 0; n < 2; ++n) gv[bj][n] = *(const f32x4*)(gp + bj * 128 + n * 4);
        bf16* sp = slab + (size_t)u.ks * NRC * D;
#pragma unroll
        for (int ai = 0; ai < 2; ++ai)
#pragma unroll
            for (int m = 0; m < 4; ++m) {
                const int R = u.pm * 256 + ai * 128 + wr * 64 + m * 16 + fr;
                bf16* xp = sp + (size_t)R * D + c0;
#pragma unroll
                for (int bj = 0; bj < 2; ++bj) { const f32x4 p0 = gv[bj][0] * acc[ai][bj][m][0], p1 = gv[bj][1] * acc[ai][bj][m][1];
                    v4u w; w.x = pg8::cvt_pk_bf16(p0[0], p0[1]); w.y = pg8::cvt_pk_bf16(p0[2], p0[3]); w.z = pg8::cvt_pk_bf16(p1[0], p1[1]); w.w = pg8::cvt_pk_bf16(p1[2], p1[3]);
                    *(v4u*)(xp + bj * 128) = w; } }
    }
};
struct CtxSplitOrder {
    int G, c, npn, t_hi, n_hi;
    __device__ __forceinline__ bool next(int i, pg8::Unit& u) const {
        const int L = i * G + c; if (L >= 32 * npn) return false;
        const int ks = L & 7, rest = L >> 3; u.pn = rest % npn; u.pm = rest / npn; u.ks = ks;
        u.nt = ks < n_hi ? t_hi : t_hi - 2; u.k0 = 64 * (ks < n_hi ? ks * t_hi : n_hi * t_hi + (ks - n_hi) * (t_hi - 2)); return true;
    }
    __device__ __forceinline__ void a_ready(const pg8::Unit&) const {}
    __device__ __forceinline__ void done(const pg8::Unit&) const {}
};
struct ResCtxOrder {
    int G, c, t_full, t_hi, n_hi; bool with_ctx;
    __device__ __forceinline__ void init(int G_, int c_, int K, bool wc, int t_hi_, int n_hi_) { G = G_; c = c_; t_full = K / 64; t_hi = t_hi_; n_hi = n_hi_; with_ctx = wc; }
    __device__ __forceinline__ bool next(int i, pg8::Unit& u) const {
        constexpr int NLAT = (NRL / 256) * (D / 256);
        const int L = i * G + c;
        int pm, pn, k0, nt, ks; bool ok = true;
        if (L < NLAT) {
            int wgid = L; { const int q = NLAT / pg8::NXCD, xcd = wgid % pg8::NXCD, off = wgid / pg8::NXCD; wgid = xcd * q + off; }
            const int nig = pg8::WGM * (D / 256), gid = wgid / nig, fm = gid * pg8::WGM;
            pm = 4 + fm + ((wgid % nig) % pg8::WGM); pn = (wgid % nig) / pg8::WGM; k0 = 0; nt = t_full; ks = -1;
        } else {
            const int Lc = L - ((NLAT + G - 1) / G) * G;
            ok = with_ctx && Lc >= 0 && Lc < 32 * 8;
            ks = Lc & 7; const int rest = Lc >> 3; pn = rest & 7; pm = (rest >> 3) & 3;
            nt = ks < n_hi ? t_hi : t_hi - 2; k0 = 64 * (ks < n_hi ? ks * t_hi : n_hi * t_hi + (ks - n_hi) * (t_hi - 2));
        }
        u.pm = pm; u.pn = pn; u.k0 = k0; u.nt = nt; u.ks = ks; return ok;
    }
    __device__ __forceinline__ void a_ready(const pg8::Unit&) const {}
    __device__ __forceinline__ void done(const pg8::Unit&) const {}
};
struct EpiResSlab {
    static constexpr bool PERM = true, AFTER_DRAIN = false;
    static constexpr int NOPS = 12;
    bf16* X; bf16* slab; const float* mod; int gidx;
    __device__ __forceinline__ void operator()(const pg8::f32x4 (&acc)[2][2][4][2], const pg8::Unit& u, int wr, int wc, int fr, int fq) const {
        const bool lat = u.ks < 0;
        const int r = row_r(u.pm); const int c0 = u.pn * 256 + wc * 32 + 8 * fq;
        const float* gp = mod + (size_t)(r * 6 + gidx) * D + c0;
        f32x4 gv[2][2];
#pragma unroll
        for (int bj = 0; bj < 2; ++bj)
#pragma unroll
            for (int n = 0; n < 2; ++n) gv[bj][n] = *(const f32x4*)(gp + bj * 128 + n * 4);
        const int rs = lat ? 256 : D;
        bf16* dst = lat ? X + xblk(u.pm * 256 + wr * 64 + fr, c0) : slab + (size_t)u.ks * NRC * D + (size_t)(u.pm * 256 + wr * 64 + fr) * D + c0;
        v4u bs[2][4][2];
#pragma unroll
        for (int ai = 0; ai < 2; ++ai)
#pragma unroll
            for (int m = 0; m < 4; ++m)
#pragma unroll
                for (int bj = 0; bj < 2; ++bj) bs[ai][m][bj] = (v4u){0u, 0u, 0u, 0u};
        if (lat) {
#pragma unroll
            for (int ai = 0; ai < 2; ++ai)
#pragma unroll
                for (int m = 0; m < 4; ++m)
#pragma unroll
                    for (int bj = 0; bj < 2; ++bj) bs[ai][m][bj] = *(const v4u*)(dst + (size_t)((ai * 128 + m * 16) * rs) + bj * 128); }
        asm volatile("" ::: "memory");
#pragma unroll
        for (int ai = 0; ai < 2; ++ai)
#pragma unroll
            for (int m = 0; m < 4; ++m)
#pragma unroll
                for (int bj = 0; bj < 2; ++bj) {
                    const v4u bw = bs[ai][m][bj]; const f32x4 a0 = acc[ai][bj][m][0], a1 = acc[ai][bj][m][1], ga = gv[bj][0], gb = gv[bj][1];
                    v4u w; w.x = pg8::cvt_pk_bf16(bflo(bw.x) + ga[0] * a0[0], bfhi(bw.x) + ga[1] * a0[1]); w.y = pg8::cvt_pk_bf16(bflo(bw.y) + ga[2] * a0[2], bfhi(bw.y) + ga[3] * a0[3]);
                    w.z = pg8::cvt_pk_bf16(bflo(bw.z) + gb[0] * a1[0], bfhi(bw.z) + gb[1] * a1[1]); w.w = pg8::cvt_pk_bf16(bflo(bw.w) + gb[2] * a1[2], bfhi(bw.w) + gb[3] * a1[3]);
                    *(v4u*)(dst + (size_t)((ai * 128 + m * 16) * rs) + bj * 128) = w; }
    }
};
struct EpiMli {
    static constexpr bool PERM = true, AFTER_DRAIN = false;
    bf16 *Q, *K, *V, *O; float* GATES; const float* bg;
    static constexpr int NOPS = 0;
    __device__ __forceinline__ void operator()(const pg8::f32x4 (&acc)[2][2][4][2], const pg8::Unit& u, int wr, int wc, int fr, int fq) const {
        const int pn = u.pn;
        if (pn < 24) {
            bf16* base; int ldc, colt; float sc = 1.f;
            if (pn < 4) { base = Q; ldc = 1024; colt = pn * 256; sc = 0.08838834764831845f; } else if (pn < 8) { base = K; ldc = 1024; colt = (pn - 4) * 256; }
            else if (pn < 16) { base = V; ldc = D; colt = (pn - 8) * 256; } else { base = O; ldc = D; colt = (pn - 16) * 256; }
            const int col0 = colt + wc * 32 + 8 * fq;
#pragma unroll
            for (int ai = 0; ai < 2; ++ai)
#pragma unroll
                for (int m = 0; m < 4; ++m) {
                    const int R = u.pm * 256 + ai * 128 + wr * 64 + m * 16 + fr; bf16* rowp = base + (size_t)R * ldc + col0;
#pragma unroll
                    for (int bj = 0; bj < 2; ++bj) { const f32x4 v0 = acc[ai][bj][m][0] * sc, v1 = acc[ai][bj][m][1] * sc; v4u w;
                        w.x = pg8::cvt_pk_bf16(v0[0], v0[1]); w.y = pg8::cvt_pk_bf16(v0[2], v0[3]); w.z = pg8::cvt_pk_bf16(v1[0], v1[1]); w.w = pg8::cvt_pk_bf16(v1[2], v1[3]);
                        if (pn >= 16) __builtin_nontemporal_store(w, (v4u*)(rowp + bj * 128)); else *(v4u*)(rowp + bj * 128) = w; } }
        } else if (wc == 0) {
#pragma unroll
            for (int ai = 0; ai < 2; ++ai)
#pragma unroll
                for (int m = 0; m < 4; ++m) {
                    const int R = u.pm * 256 + ai * 128 + wr * 64 + m * 16 + fr;
#pragma unroll
                    for (int n = 0; n < 2; ++n) { const int gc = 8 * fq + 4 * n; const f32x4 bv = *(const f32x4*)(bg + gc); f32x4 o;
#pragma unroll
                        for (int e = 0; e < 4; ++e) { const float z = (acc[ai][0][m][n][e] + bv[e]) * (1.0f / 15.0f); float gcap = 15.0f * tanhf(z);
                            if (fq & 1) gcap = fminf(gcap, 0.f) - log1pf(expf(-fabsf(gcap)));
                            o[e] = gcap; }
                        *(f32x4*)(GATES + (size_t)R * 32 + gc) = o; } }
        }
    }
};

__device__ __forceinline__ void transpose_item(const float* W, int K, int N, bf16* WT, int kb, int n0, int drow0, float sc, LAS float* scr, int lane) {
    const int k0 = 64 * kb;
#pragma unroll 8
    for (int i = 0; i < 32; ++i) { const int kk = 2 * i + (lane >> 5); scr[kk * 33 + (lane & 31)] = __builtin_nontemporal_load(W + (size_t)(k0 + kk) * N + n0 + (lane & 31)); }
    asm volatile("s_waitcnt lgkmcnt(0)" ::: "memory");
    const int c = lane & 7;
#pragma unroll
    for (int j = 0; j < 4; ++j) { const int n = (lane >> 3) + 8 * j; const LAS float* s = scr + (8 * c) * 33 + n;
        v4u o; o.x = pk2(s[0 * 33] * sc, s[1 * 33] * sc); o.y = pk2(s[2 * 33] * sc, s[3 * 33] * sc); o.z = pk2(s[4 * 33] * sc, s[5 * 33] * sc); o.w = pk2(s[6 * 33] * sc, s[7 * 33] * sc);
        __builtin_nontemporal_store(o, (v4u*)(WT + (size_t)(drow0 + n) * K + k0 + 8 * c)); }
    asm volatile("s_waitcnt lgkmcnt(0)" ::: "memory");
}
__device__ __forceinline__ int pair_row(int n0, int F) { const int j0 = n0 < F ? n0 : n0 - F; return 256 * (j0 >> 7) + (j0 & 127) + (n0 < F ? 0 : 128); }

constexpr int I_FFI = 32 * 352, I_FFO = 88 * 64, I_GLU = 32 * 128, I_MLI = 32 * 193, I_MLO = 32 * 64;
constexpr int TRG_S5 = I_GLU + I_FFI + I_FFO, TRG_ML = I_MLI + I_MLO + I_FFI + I_FFO;
constexpr int TR_L1 = TRG_S5, TR_L2 = TR_L1 + TRG_ML, TR_L3 = TR_L2 + TRG_S5, TR_END = TR_L3 + TRG_ML;
struct TrItem { const float* W; bf16* WT; int K, N, kb, n0, drow0; float sc; };
__device__ __forceinline__ int pair_row_(int n0, int F) { const int j0 = n0 < F ? n0 : n0 - F; return 256 * (j0 >> 7) + (j0 & 127) + (n0 < F ? 0 : 128); }
__device__ __forceinline__ TrItem tr_decode(const float* w_ffi, const float* w_ffo, const float* w_glu, const float* w_mli, const float* w_mlo, unsigned char* ws, int it) {
    TrItem t; int layer, r; t.sc = 1.0f;
    if (it < TR_L1) { layer = 0; r = it; } else if (it < TR_L2) { layer = 1; r = it - TR_L1; } else if (it < TR_L3) { layer = 2; r = it - TR_L2; } else { layer = 3; r = it - TR_L3; }
    const int j = layer >> 1;
    if ((layer & 1) == 0) {
        if (r < I_GLU) { t.W = w_glu + (size_t)j * D * 2 * D; t.WT = (bf16*)(ws + WS_WGLU + j * SZ_WGLU); t.K = D; t.N = 2 * D; t.kb = r / 128; t.n0 = 32 * (r % 128); t.drow0 = pair_row_(t.n0, D); t.sc = t.n0 < D ? 1.0f : -1.4426950408889634f; return t; }
        r -= I_GLU;
    } else {
        if (r < I_MLI) { t.W = w_mli + (size_t)j * D * MLIN; t.WT = (bf16*)(ws + WS_WMLI + j * SZ_WMLI); t.K = D; t.N = MLIN; t.kb = r / 193; t.n0 = 32 * (r % 193); t.drow0 = t.n0; return t; }
        r -= I_MLI;
        if (r < I_MLO) { t.W = w_mlo + (size_t)j * D * D; t.WT = (bf16*)(ws + WS_WMLO + j * SZ_WMLO); t.K = D; t.N = D; t.kb = r / 64; t.n0 = 32 * (r % 64); t.drow0 = t.n0; return t; }
        r -= I_MLO;
    }
    if (r < I_FFI) { t.W = w_ffi + (size_t)layer * D * 2 * FF; t.WT = (bf16*)(ws + WS_WFFI + layer * SZ_WFFI); t.K = D; t.N = 2 * FF; t.kb = r / 352; t.n0 = 32 * (r % 352); t.drow0 = pair_row_(t.n0, FF); t.sc = t.n0 < FF ? 1.4426950408889634f : 0.6931471805599453f; return t; }
    r -= I_FFI;
    t.W = w_ffo + (size_t)layer * FF * D; t.WT = (bf16*)(ws + WS_WFFO + layer * SZ_WFFO); t.K = FF; t.N = D; t.kb = r / 64; t.n0 = 32 * (r % 64); t.drow0 = t.n0; return t;
}
#ifndef TQ_G
#define TQ_G 13
#endif
#ifndef TQ_F
#define TQ_F 16
#endif
#ifndef TQ_M
#define TQ_M 11
#endif
constexpr int imin(int a, int b) { return a < b ? a : b; }
constexpr int imax(int a, int b) { return a > b ? a : b; }
constexpr int CAP_G = 192 * 8 * TQ_G, CAP_F = 80 * 8 * TQ_F, CAP_M = 92 * 8 * TQ_M;
constexpr int P_END = imax(0, TR_END - (2 * CAP_G + 3 * CAP_F + 2 * CAP_M));
constexpr int TAIL_GLU0_LO = P_END,        TAIL_GLU0_HI = TAIL_GLU0_LO + CAP_G;
constexpr int TAIL_FFI0_LO = TAIL_GLU0_HI, TAIL_FFI0_HI = TAIL_FFI0_LO + CAP_F;
constexpr int TAIL_MLI1_LO = TAIL_FFI0_HI, TAIL_MLI1_HI = TAIL_MLI1_LO + CAP_M;
constexpr int TAIL_FFI1_LO = TAIL_MLI1_HI, TAIL_FFI1_HI = TAIL_FFI1_LO + CAP_F;
constexpr int TAIL_GLU2_LO = TAIL_FFI1_HI, TAIL_GLU2_HI = TAIL_GLU2_LO + CAP_G;
constexpr int TAIL_FFI2_LO = TAIL_GLU2_HI, TAIL_FFI2_HI = TAIL_FFI2_LO + CAP_F;
constexpr int TAIL_MLI3_LO = TAIL_FFI2_HI, TAIL_MLI3_HI = imin(TAIL_MLI3_LO + CAP_M, TR_END);
static_assert(P_END > 0 && TAIL_MLI3_HI == TR_END, "tail capacities must not exceed the item count");
static_assert(TAIL_GLU0_LO >= I_GLU, "GLU0 tail: first item must be read after GLU0");
static_assert(TAIL_FFI0_LO >= I_GLU + I_FFI, "FFI0 tail: first item must be read after FFI0");
static_assert(TAIL_MLI1_LO >= TR_L1 + I_MLI, "MLI1 tail: first item must be read after MLI1");
static_assert(TAIL_FFI1_LO >= TR_L1 + I_MLI + I_MLO + I_FFI, "FFI1 tail: first item must be read after FFI1");
static_assert(TAIL_GLU2_LO >= TR_L2 + I_GLU, "GLU2 tail: first item must be read after GLU2");
static_assert(TAIL_FFI2_LO >= TR_L2 + I_GLU + I_FFI, "FFI2 tail: first item must be read after FFI2");
static_assert(TAIL_MLI3_LO >= TR_L3 + I_MLI, "MLI3 tail: first item must be read after MLI3");
constexpr int PRO_N = P_END;
__device__ __forceinline__ int pro_item(int it) { return it; }
struct Ctx {
    const float* in[24]; unsigned char* ws;
    LAS unsigned char* lds; int tid, lane, wave, vcu, G, bx;
};

__device__ __forceinline__ void pro_convert(const Ctx& c, LAS float* scr);
__device__ __forceinline__ void phase_prologue(const Ctx& c) {
    LAS float* scr = (LAS float*)(c.lds + c.wave * 16384);
    const int gw = c.vcu * NWAVES + c.wave, NGW = c.G * NWAVES;
#ifndef PROBE_PRO
#define PROBE_PRO 0
#endif
    for (int rpp = 0; rpp < ((PROBE_PRO & 1) ? 2 : 1); ++rpp)
    pro_convert(c, scr);
    { const int gt = c.vcu * 512 + c.tid, NGT = c.G * 512; constexpr int PADV = (MLINP - MLIN) * D * 2 / 16;
        for (int i = gt; i < 2 * PADV; i += NGT) { const int l = i / PADV, v = i % PADV; *(v4u*)(c.ws + WS_WMLI + l * SZ_WMLI + (size_t)MLIN * D * 2 + (size_t)v * 16) = (v4u){0u, 0u, 0u, 0u}; } }
    __syncthreads();
    LAS float* sc = (LAS float*)c.lds;
    LAS float* red = (LAS float*)(c.lds + 40960);
    { const int k4 = 4 * c.tid; f32x4 cv[5];
#pragma unroll
        for (int r = 0; r < 4; ++r) cv[r] = *(const f32x4*)(c.in[1] + r * D + k4);
        cv[4] = *(const f32x4*)(c.in[3] + k4);
#pragma unroll
        for (int r = 0; r < 5; ++r) { f32x4 o;
#pragma unroll
            for (int e = 0; e < 4; ++e) o[e] = cv[r][e] * fsigmoid(cv[r][e]);
            *(LAS f32x4*)(sc + r * D + k4) = o; } }
    __syncthreads();
    const int cl = c.tid & 15, kg = c.tid >> 4;
    float* mod = (float*)(c.ws + WS_MOD);
    for (int rpa = 0; rpa < ((PROBE_PRO & 2) ? 2 : 1); ++rpa)
    for (int u = c.vcu; u < 768; u += c.G) {
        const int layer = u / 192, cb = u % 192;
        const float* W = c.in[4] + (size_t)layer * D * 6 * D + cb * 64 + cl * 4;
        float acc[5][4];
#pragma unroll
        for (int r = 0; r < 5; ++r)
#pragma unroll
            for (int e = 0; e < 4; ++e) acc[r][e] = 0.f;
#pragma unroll 8
        for (int kk = 0; kk < 64; ++kk) { const int k = kg + 32 * kk; const f32x4 w = __builtin_nontemporal_load((const f32x4*)(W + (size_t)k * (6 * D)));
#pragma unroll
            for (int r = 0; r < 5; ++r) { const float s = sc[r * D + k];
#pragma unroll
                for (int e = 0; e < 4; ++e) acc[r][e] += s * w[e]; } }
#pragma unroll
        for (int r = 0; r < 5; ++r)
#pragma unroll
            for (int e = 0; e < 4; ++e) red[(r * 4 + e) * 512 + c.tid] = acc[r][e];
        __syncthreads();
        if (c.tid < 320) { const int r = c.tid / 64, cc = c.tid % 64, cl2 = cc >> 2, e = cc & 3; float s = 0.f;
#pragma unroll 8
            for (int g = 0; g < 32; ++g) s += red[(r * 4 + e) * 512 + g * 16 + cl2];
            const int col = cb * 64 + cc; mod[(size_t)(layer * 5 + r) * 6 * D + col] = s + c.in[5][layer * 6 * D + col]; }
        __syncthreads();
    }
}

__device__ __forceinline__ void tr_issue(const TrItem& t, float (&rt)[32], int lane) {
    const float* wp = t.W + (size_t)(64 * t.kb + (lane >> 5)) * t.N + t.n0 + (lane & 31);
#pragma unroll
    for (int i = 0; i < 32; ++i) rt[i] = __builtin_nontemporal_load(wp + (size_t)(2 * i) * t.N);
}
__device__ __forceinline__ void tr_finish(const TrItem& t, const float (&rt)[32], LAS float* scr, int lane) {
#pragma unroll
    for (int i = 0; i < 32; ++i) scr[(2 * i + (lane >> 5)) * 33 + (lane & 31)] = rt[i];
    asm volatile("s_waitcnt lgkmcnt(0)" ::: "memory");
    const int cidx = lane & 7, k0 = 64 * t.kb; const float sc = t.sc;
#pragma unroll
    for (int j = 0; j < 4; ++j) { const int n = (lane >> 3) + 8 * j; const LAS float* s = scr + (8 * cidx) * 33 + n;
        v4u o; o.x = pk2(s[0 * 33] * sc, s[1 * 33] * sc); o.y = pk2(s[2 * 33] * sc, s[3 * 33] * sc); o.z = pk2(s[4 * 33] * sc, s[5 * 33] * sc); o.w = pk2(s[6 * 33] * sc, s[7 * 33] * sc);
        __builtin_nontemporal_store(o, (v4u*)(t.WT + (size_t)(t.drow0 + n) * t.K + k0 + 8 * cidx)); }
    asm volatile("s_waitcnt lgkmcnt(0)" ::: "memory");
}
#define TR_DEC(i_) tr_decode(c.in[22], c.in[23], c.in[17], c.in[18], c.in[21], c.ws, (i_))
__device__ __forceinline__ void tail_convert(const Ctx& c, int nunits, int lo, int hi) {
    const int nfull = nunits % c.G;
    if (nfull == 0 || c.bx < nfull || lo >= hi) return;
    LAS float* scr = (LAS float*)(c.lds + c.wave * 16384);
    const int wv = (c.bx - nfull) * NWAVES + c.wave, nwv = (c.G - nfull) * NWAVES;
    float rtA[32], rtB[32];
    int ia = lo + wv, ib = ia + nwv;
    if (ia < hi) { const TrItem t = TR_DEC(ia); tr_issue(t, rtA, c.lane); }
    if (ib < hi) { const TrItem t = TR_DEC(ib); tr_issue(t, rtB, c.lane); }
    while (ia < hi) {
        { const TrItem t = TR_DEC(ia); tr_finish(t, rtA, scr, c.lane); } ia += 2 * nwv; if (ia < hi) { const TrItem t = TR_DEC(ia); tr_issue(t, rtA, c.lane); }
        if (ib < hi) { { const TrItem t = TR_DEC(ib); tr_finish(t, rtB, scr, c.lane); } ib += 2 * nwv; if (ib < hi) { const TrItem t = TR_DEC(ib); tr_issue(t, rtB, c.lane); } }
    }
}
__device__ __forceinline__ void pro_convert(const Ctx& c, LAS float* scr) {
    const int gw = c.vcu * NWAVES + c.wave, NGW = c.G * NWAVES;
    float rtA[32], rtB[32];
    int ia = gw, ib = gw + NGW;
    if (ia < PRO_N) { const TrItem t = TR_DEC(pro_item(ia)); tr_issue(t, rtA, c.lane); }
    if (ib < PRO_N) { const TrItem t = TR_DEC(pro_item(ib)); tr_issue(t, rtB, c.lane); }
    while (ia < PRO_N) {
        { const TrItem t = TR_DEC(pro_item(ia)); tr_finish(t, rtA, scr, c.lane); } ia += 2 * NGW; if (ia < PRO_N) { const TrItem t = TR_DEC(pro_item(ia)); tr_issue(t, rtA, c.lane); }
        if (ib < PRO_N) { { const TrItem t = TR_DEC(pro_item(ib)); tr_finish(t, rtB, scr, c.lane); } ib += 2 * NGW; if (ib < PRO_N) { const TrItem t = TR_DEC(pro_item(ib)); tr_issue(t, rtB, c.lane); } }
    }
}
#undef TR_DEC

template <bool SRC32> struct NormRaw;
template <> struct NormRaw<true> { f32x4 q[8]; };
template <> struct NormRaw<false> { v2u q[8]; };
template <bool SRC32> __device__ __forceinline__ void norm_loadrow(NormRaw<SRC32>& w, const void* ctxsrc, const void* latsrc, int R, int lane) {
    if constexpr (SRC32) { const float* xr = (R < NRC ? (const float*)ctxsrc + (size_t)R * D : (const float*)latsrc + (size_t)(R - NRC) * D) + 4 * lane;
#pragma unroll
        for (int j = 0; j < 8; ++j) w.q[j] = __builtin_nontemporal_load((const f32x4*)(xr + 256 * j)); }
    else { const bf16* xr = (const bf16*)ctxsrc + xblk(R, 0) + 4 * lane;
#pragma unroll
        for (int j = 0; j < 8; ++j) w.q[j] = __builtin_nontemporal_load((const v2u*)(xr + ((size_t)j << 16))); }
}
template <bool SRC32> __device__ __forceinline__ f32x4 norm_cvt(const NormRaw<SRC32>& w, int j) {
    if constexpr (SRC32) return w.q[j]; else return (f32x4){bflo(w.q[j].x), bfhi(w.q[j].x), bflo(w.q[j].y), bfhi(w.q[j].y)};
}
template <bool MLP, bool SRC32> __device__ __forceinline__ void phase_norm(const Ctx& c, const void* ctxsrc, const void* latsrc, const float* g, const float* modl, int shift_idx, int scale_idx, bf16* U, const bf16* slab, bf16* Xw, int r_lo) {
    LAS float* wn = (LAS float*)c.lds; LAS float* sh = (LAS float*)(c.lds + 40960);
    __syncthreads();
    { const int col = 4 * c.tid;
        const f32x4 g4 = *(const f32x4*)(g + col); f32x4 sc4[5], sh4[5];
#pragma unroll
        for (int r = 0; r < 5; ++r) { sc4[r] = *(const f32x4*)(modl + (size_t)(r * 6 + scale_idx) * D + col); sh4[r] = *(const f32x4*)(modl + (size_t)(r * 6 + shift_idx) * D + col); }
#pragma unroll
        for (int r = 0; r < 5; ++r) { *(LAS f32x4*)(wn + r * D + col) = g4 * (1.0f + sc4[r]); *(LAS f32x4*)(sh + r * D + col) = sh4[r]; } }
    __syncthreads();
    const int gw = c.wave * c.G + c.vcu, NGW = c.G * NWAVES;
    int R = r_lo + gw;
    NormRaw<SRC32> wA, wB, wC;
    const bool deal = false;
    auto rmap = [&](const int Rl) __attribute__((always_inline)) {
        const int idx = ((Rl >> 3) << 2) | (Rl & 3); return (deal && Rl < 2 * NRC) ? ((Rl & 4) ? NRC + idx : idx) : Rl; };
    auto ld = [&](NormRaw<SRC32>& w, const int Rl) __attribute__((always_inline)) { if (Rl < NR) norm_loadrow<SRC32>(w, ctxsrc, latsrc, rmap(Rl), c.lane); };
    auto proc = [&](const int Rl, const NormRaw<SRC32>& w0) __attribute__((always_inline)) {
        const int R = rmap(Rl);
        f32x4 v[8];
#pragma unroll
        for (int j = 0; j < 8; ++j) v[j] = norm_cvt<SRC32>(w0, j);
        int r, dstR;
        if (R < NRC) { r = 4; dstR = R;
            if (slab) {
                v2u sl[8][8];
#pragma unroll
                for (int sidx = 0; sidx < 8; ++sidx) { const bf16* sp = slab + ((size_t)sidx * NRC + R) * D + 4 * c.lane;
#pragma unroll
                    for (int j = 0; j < 8; ++j) sl[sidx][j] = __builtin_nontemporal_load((const v2u*)(sp + 256 * j)); }
                asm volatile("" ::: "memory");
#pragma unroll
                for (int sidx = 0; sidx < 8; ++sidx)
#pragma unroll
                    for (int j = 0; j < 8; ++j) { const v2u pw = sl[sidx][j]; v[j] += (f32x4){bflo(pw.x), bfhi(pw.x), bflo(pw.y), bfhi(pw.y)}; }
#pragma unroll
                for (int j = 0; j < 8; ++j) { v2u xw; xw.x = pk2(v[j][0], v[j][1]); xw.y = pk2(v[j][2], v[j][3]); *(v2u*)(Xw + xblk(R, 0) + ((size_t)j << 16) + 4 * c.lane) = xw; } } }
        else { const int q = R - NRC, s = q & 4095; r = q >> 12; dstR = MLP ? NRC + (q & ~4095) + ((s & 63) << 6) + (s >> 6) : R; }
        float ss = 0.f;
#pragma unroll
        for (int j = 0; j < 8; ++j) ss += (v[j][0] * v[j][0] + v[j][1] * v[j][1]) + (v[j][2] * v[j][2] + v[j][3] * v[j][3]);
        const float rs = __builtin_amdgcn_rsqf(wave_sum(ss) * (1.0f / D) + EPSN);
        bf16* orow = U + (size_t)dstR * D;
#pragma unroll
        for (int j = 0; j < 8; ++j) { const int col = 4 * c.lane + 256 * j; const f32x4 ww = *(const LAS f32x4*)(wn + r * D + col), hv = *(const LAS f32x4*)(sh + r * D + col);
            v2u w; w.x = pk2(v[j][0] * rs * ww[0] + hv[0], v[j][1] * rs * ww[1] + hv[1]); w.y = pk2(v[j][2] * rs * ww[2] + hv[2], v[j][3] * rs * ww[3] + hv[3]); *(v2u*)(orow + col) = w; }
    };
    ld(wA, R); ld(wB, R + NGW);
    while (R < NR) {
        ld(wC, R + 2 * NGW); proc(R, wA); R += NGW; if (R >= NR) break;
        ld(wA, R + 2 * NGW); proc(R, wB); R += NGW; if (R >= NR) break;
        ld(wB, R + 2 * NGW); proc(R, wC); R += NGW;
    }
}
__device__ __forceinline__ void phase_final(const Ctx& c, const bf16* X, const float* g, float* out) {
    const int gw = c.vcu * NWAVES + c.wave, NGW = c.G * NWAVES;
    int q = gw; NormRaw<false> wA, wB, wC;
    const bf16* XL = X;
    f32x4 gg[8];
#pragma unroll
    for (int j = 0; j < 8; ++j) gg[j] = *(const f32x4*)(g + 4 * c.lane + 256 * j);
    auto ld = [&](NormRaw<false>& w, const int qq) __attribute__((always_inline)) { if (qq < NRL) norm_loadrow<false>(w, XL, XL, NRC + qq, c.lane); };
    auto proc = [&](const int q, const NormRaw<false>& w0) __attribute__((always_inline)) {
        f32x4 v[8];
#pragma unroll
        for (int j = 0; j < 8; ++j) v[j] = norm_cvt<false>(w0, j);
        float ss = 0.f;
#pragma unroll
        for (int j = 0; j < 8; ++j) ss += (v[j][0] * v[j][0] + v[j][1] * v[j][1]) + (v[j][2] * v[j][2] + v[j][3] * v[j][3]);
        const float rs = __builtin_amdgcn_rsqf(wave_sum(ss) * (1.0f / D) + EPSN);
#pragma unroll
        for (int j = 0; j < 8; ++j) __builtin_nontemporal_store(v[j] * rs * gg[j], (f32x4*)(out + (size_t)q * D + 4 * c.lane + 256 * j));
    };
    ld(wA, q); ld(wB, q + NGW);
    while (q < NRL) {
        ld(wC, q + 2 * NGW); proc(q, wA); q += NGW; if (q >= NRL) break;
        ld(wA, q + 2 * NGW); proc(q, wB); q += NGW; if (q >= NRL) break;
        ld(wB, q + 2 * NGW); proc(q, wC); q += NGW;
    }
}

__device__ __forceinline__ int s5_rowbase(int b, int dir, int bi) {
    if (bi < 16) { const int cb = dir ? 15 - bi : bi; return b * 256 + cb * 16; }
    const int cb0 = bi - 16, cb = dir ? 255 - cb0 : cb0; return NRC + b * 4096 + cb * 16;
}
typedef float f32x16 __attribute__((ext_vector_type(16)));
__device__ __forceinline__ v2u s5_fin4(f32x4 y, v2u pw, v2u uw, f32x4 d4) {
    y[0] += bflo(pw.x) + d4[0] * bflo(uw.x); y[1] += bfhi(pw.x) + d4[1] * bfhi(uw.x); y[2] += bflo(pw.y) + d4[2] * bflo(uw.y); y[3] += bfhi(pw.y) + d4[3] * bfhi(uw.y);
#pragma unroll
    for (int e = 0; e < 4; ++e) { const float x = y[e];
        const float arg = x * fmaf(x * x, -0.10294324f, -2.30220820f); y[e] = x * __builtin_amdgcn_rcpf(1.0f + __builtin_amdgcn_exp2f(arg)); }
    return (v2u){pk2(y[0], y[1]), pk2(y[2], y[3])};
}
__device__ __forceinline__ void phase_s5_scan3(const Ctx& c, int j, const bf16* U, bf16* YF, bf16* YB, const float* dsk, bf16* Gout) {
    const float* lam_re = c.in[9]; const float* lam_im = c.in[10]; const float* log_dt = c.in[11];
    const float* b_re = c.in[12]; const float* b_im = c.in[13]; const float* c_re = c.in[14]; const float* c_im = c.in[15];
    const int lane = c.lane, w = c.wave, r = lane & 31, hh = lane >> 5, l15 = lane & 15, g4 = lane >> 4;
    for (int u = c.vcu; u < 256; u += c.G) {
        const int g = u >> 1, dir = u & 1;
        const size_t pg = (size_t)(j * 2 + dir) * 128 + g;
        bf16* Y = dir ? YB : YF;
        __syncthreads();
        if (w < 4) {
            __builtin_amdgcn_s_setprio(2);
            const int bp = w >> 1, sg = w & 1, p = 32 * sg + r, bme = 2 * bp + hh;
            const float dt = expf(log_dt[pg]);
            const float lre = lam_re[pg * 64 + p], lim = lam_im[pg * 64 + p];
            const float mag = expf(lre * dt); float sn, cs; sincosf(lim * dt, &sn, &cs);
            const float are = mag * cs, aim = mag * sn;
            const float den = lre * lre + lim * lim;
            const float fre = ((are - 1.0f) * lre + aim * lim) / den, fim = (aim * lre - (are - 1.0f) * lim) / den;
            bf16x8 Bfr, Bfi;
            { const f32x4 br0 = *(const f32x4*)(b_re + (pg * 64 + p) * 16 + 8 * hh), br1 = *(const f32x4*)(b_re + (pg * 64 + p) * 16 + 8 * hh + 4);
              const f32x4 bi0 = *(const f32x4*)(b_im + (pg * 64 + p) * 16 + 8 * hh), bi1 = *(const f32x4*)(b_im + (pg * 64 + p) * 16 + 8 * hh + 4);
#pragma unroll
              for (int e = 0; e < 4; ++e) { Bfr[e] = (short)f2bf(fre * br0[e] - fim * bi0[e]); Bfr[4 + e] = (short)f2bf(fre * br1[e] - fim * bi1[e]);
                  Bfi[e] = (short)f2bf(fre * bi0[e] + fim * br0[e]); Bfi[4 + e] = (short)f2bf(fre * bi1[e] + fim * br1[e]); } }
            const int hrow = (r >> 2) & 1, tst = 4 * (r >> 3) + (r & 3), toff = dir ? 15 - tst : tst, brow = 2 * bp + hrow;
            const bf16* up = U + (size_t)g * 16 + 8 * hh;
            bf16x8 ring[8];
#pragma unroll
            for (int k = 0; k < 8; ++k) ring[k] = *(const bf16x8*)(up + (size_t)(s5_rowbase(brow, dir, k) + toff) * D);
            float sre = 0.f, sim = 0.f;
            f32x16 z;
#pragma unroll
            for (int e = 0; e < 16; ++e) z[e] = 0.f;
            f32x16 hrn = __builtin_amdgcn_mfma_f32_32x32x16_bf16(ring[0], Bfr, z, 0, 0, 0), hin = __builtin_amdgcn_mfma_f32_32x32x16_bf16(ring[0], Bfi, z, 0, 0, 0);
            ring[0] = *(const bf16x8*)(up + (size_t)(s5_rowbase(brow, dir, 8) + toff) * D);
            const int sg16 = dir ? -16 : 16, dS = NRC + brow * 3840 + (dir ? 4080 : -240);
            const bf16* upn = up + (size_t)(s5_rowbase(brow, dir, 9) + toff) * D; int nb = 9;
            for (int bb = 0; bb < 272; bb += 8) {
#pragma unroll
              for (int k = 0; k < 8; ++k) {
                const int bi = bb + k;
                const f32x16 hr = hrn, hi = hin;
                { const int kn = (k + 1) & 7; const bf16x8 unx = ring[kn];
                  hrn = __builtin_amdgcn_mfma_f32_32x32x16_bf16(unx, Bfr, z, 0, 0, 0); hin = __builtin_amdgcn_mfma_f32_32x32x16_bf16(unx, Bfi, z, 0, 0, 0);
                  ring[kn] = *(const bf16x8*)upn;
                  if (nb < 271) { const long dr = nb == 15 ? dS : sg16; upn += dr * D; ++nb; } }
                LAS unsigned char* hb = c.lds + (bme * 2 + ((bi >> 1) & 1)) * 8704 + (bi & 1) * 4352 + 4 * p;
#pragma unroll
                for (int e = 0; e < 16; ++e) { float nre = fmaf(are, sre, fmaf(-aim, sim, hr[e])); asm volatile("" : "+v"(nre));
                    const float nim = fmaf(are, sim, fmaf(aim, sre, hi[e])); sre = nre; sim = nim;
                    *(LAS unsigned*)(hb + e * 272) = pg8::cvt_pk_bf16(nre, nim); }
                if (bi == 145) { __syncthreads(); __syncthreads(); }
                if (k & 1) __syncthreads();
              }
            }
            __builtin_amdgcn_s_setprio(0);
        } else {
            const int bq = w - 4;
            bf16x8 Cf[4];
#pragma unroll
            for (int ks = 0; ks < 4; ++ks) { const int p0 = 16 * ks + 4 * g4; const f32x4 cr = *(const f32x4*)(c_re + (pg * 16 + l15) * 64 + p0), ci = *(const f32x4*)(c_im + (pg * 16 + l15) * 64 + p0);
#pragma unroll
                for (int e = 0; e < 4; ++e) { Cf[ks][2 * e] = (short)f2bf(cr[e]); Cf[ks][2 * e + 1] = (short)f2bf(-ci[e]); } }
            const int sg16 = dir ? -16 : 16, dS = NRC + bq * 3840 + (dir ? 4080 : -240);
            const bf16* YP = dir ? YF : YB;
            const int rr = dir ? 15 - l15 : l15, colo = g * 16 + 4 * g4;
            const f32x4 dsk4 = *(const f32x4*)(dsk + colo);
            unsigned* s5f = (unsigned*)(c.ws + WS_CTL) + CW_S5F + j * 256;
            size_t yo = (size_t)(s5_rowbase(bq, dir, 0) + rr) * D + colo;
            const long stepE = (long)sg16 * D, seamE = (long)dS * D;
            auto do_pair = [&](const int bp2, const bool fused, const v2u (&pw)[2], const v2u (&uw)[2]) __attribute__((always_inline)) {
#pragma unroll
                for (int hf2 = 0; hf2 < 2; ++hf2) {
                    const int bi = 2 * bp2 + hf2;
                    const LAS unsigned char* hb = c.lds + (bq * 2 + (bp2 & 1)) * 8704 + hf2 * 4352;
                    f32x4 acc = {0.f, 0.f, 0.f, 0.f};
#pragma unroll
                    for (int ks = 0; ks < 4; ++ks) { const bf16x8 hf = *(const LAS bf16x8*)(hb + l15 * 272 + ks * 64 + g4 * 16);
                        acc = __builtin_amdgcn_mfma_f32_16x16x32_bf16(Cf[ks], hf, acc, 0, 0, 0); }
                    if (!fused) *(v2u*)(Y + yo) = (v2u){pg8::cvt_pk_bf16(acc[0], acc[1]), pg8::cvt_pk_bf16(acc[2], acc[3])};
                    else *(v2u*)(Gout + yo) = s5_fin4(acc, pw[hf2], uw[hf2], dsk4);
                    yo += (bi == 15 ? seamE : stepE);
                }
            };
            constexpr int PF = 4;
            v2u ppR[PF][2], uuR[PF][2];
#pragma unroll
            for (int q = 0; q < PF; ++q)
#pragma unroll
                for (int hf2 = 0; hf2 < 2; ++hf2) { ppR[q][hf2] = (v2u){0u, 0u}; uuR[q][hf2] = (v2u){0u, 0u}; }
            for (int bp2 = 0; bp2 < 72; ++bp2) { __syncthreads(); do_pair(bp2, false, ppR[0], uuR[0]); }
            asm volatile("s_waitcnt vmcnt(0)" ::: "memory");
            __syncthreads();
            if (w == 4 && lane == 0) {
                __builtin_amdgcn_fence(__ATOMIC_RELEASE, "agent");
                __hip_atomic_store(&s5f[u], 1u, __ATOMIC_RELAXED, __HIP_MEMORY_SCOPE_AGENT);
                unsigned sp = 0; while (__hip_atomic_load(&s5f[u ^ 1], __ATOMIC_RELAXED, __HIP_MEMORY_SCOPE_AGENT) == 0u) { __builtin_amdgcn_s_sleep(1); if (++sp > (1u << 22)) break; }
                __builtin_amdgcn_fence(__ATOMIC_ACQUIRE, "agent");
                asm volatile("s_waitcnt vmcnt(0)" ::: "memory"); }
            __syncthreads();
            size_t pfo = yo;
#define S5_PF_LOAD(q_) do { _Pragma("unroll") for (int hf2_ = 0; hf2_ < 2; ++hf2_) { ppR[q_][hf2_] = *(const v2u*)(YP + pfo); uuR[q_][hf2_] = *(const v2u*)(U + pfo); pfo += stepE; } } while (0)
#pragma unroll
            for (int q = 0; q < PF; ++q) S5_PF_LOAD(q);
            { v2u cow[8], cpw[8], cuw[8];
#pragma unroll
              for (int cbk = 0; cbk < 8; ++cbk) { const size_t off = (size_t)(bq * 256 + (dir ? cbk : 8 + cbk) * 16 + l15) * D + colo; cow[cbk] = *(const v2u*)(Y + off); cpw[cbk] = *(const v2u*)(YP + off); cuw[cbk] = *(const v2u*)(U + off); }
              asm volatile("" ::: "memory");
#pragma unroll
              for (int cbk = 0; cbk < 8; ++cbk) { const size_t off = (size_t)(bq * 256 + (dir ? cbk : 8 + cbk) * 16 + l15) * D + colo;
                  *(v2u*)(Gout + off) = s5_fin4((f32x4){bflo(cow[cbk].x), bfhi(cow[cbk].x), bflo(cow[cbk].y), bfhi(cow[cbk].y)}, cpw[cbk], cuw[cbk], dsk4); } }
            for (int bb2 = 72; bb2 < 136; bb2 += PF) {
#pragma unroll
                for (int q = 0; q < PF; ++q) { const int bp2 = bb2 + q;
                    __syncthreads();
                    do_pair(bp2, true, ppR[q], uuR[q]);
                    if (bp2 + PF < 136) S5_PF_LOAD(q); }
            }
#undef S5_PF_LOAD
        }
    }
}

__device__ __forceinline__ v4u s5_comb_item(v4u uw, v4u fw, v4u bw, f32x4 d0, f32x4 d1) {
    float y[8];
    y[0] = d0[0] * bflo(uw.x) + bflo(fw.x) + bflo(bw.x); y[1] = d0[1] * bfhi(uw.x) + bfhi(fw.x) + bfhi(bw.x); y[2] = d0[2] * bflo(uw.y) + bflo(fw.y) + bflo(bw.y); y[3] = d0[3] * bfhi(uw.y) + bfhi(fw.y) + bfhi(bw.y);
    y[4] = d1[0] * bflo(uw.z) + bflo(fw.z) + bflo(bw.z); y[5] = d1[1] * bfhi(uw.z) + bfhi(fw.z) + bfhi(bw.z); y[6] = d1[2] * bflo(uw.w) + bflo(fw.w) + bflo(bw.w); y[7] = d1[3] * bfhi(uw.w) + bfhi(fw.w) + bfhi(bw.w);
#pragma unroll
    for (int e = 0; e < 8; ++e) { const float x = y[e]; const float z = 0.7978845608028654f * (x + 0.044715f * x * x * x); y[e] = x * fsigmoid(2.0f * z); }
    v4u w; w.x = pk2(y[0], y[1]); w.y = pk2(y[2], y[3]); w.z = pk2(y[4], y[5]); w.w = pk2(y[6], y[7]); return w;
}
__device__ __forceinline__ void phase_s5_combine(const Ctx& c, const float* dsk, const bf16* U, const bf16* YF, const bf16* YB, bf16* Gout) {
    const int gt = c.vcu * 512 + c.tid, NGT = c.G * 512; constexpr int NIT = NR * (D / 8);
    for (int i = gt; i < NIT; i += 2 * NGT) {
        const int i1 = i + NGT; const bool has1 = i1 < NIT;
        const size_t o0 = (size_t)i * 8, o1 = (size_t)(has1 ? i1 : i) * 8; const int c0 = (int)(o0 & (D - 1)), c1 = (int)(o1 & (D - 1));
        const v4u u0 = __builtin_nontemporal_load((const v4u*)(U + o0)), f0 = __builtin_nontemporal_load((const v4u*)(YF + o0)), b0 = __builtin_nontemporal_load((const v4u*)(YB + o0)),
                  u1 = __builtin_nontemporal_load((const v4u*)(U + o1)), f1 = __builtin_nontemporal_load((const v4u*)(YF + o1)), b1 = __builtin_nontemporal_load((const v4u*)(YB + o1));
        const f32x4 d00 = *(const f32x4*)(dsk + c0), d01 = *(const f32x4*)(dsk + c0 + 4), d10 = *(const f32x4*)(dsk + c1), d11 = *(const f32x4*)(dsk + c1 + 4);
        const v4u w0 = s5_comb_item(u0, f0, b0, d00, d01), w1 = s5_comb_item(u1, f1, b1, d10, d11);
        *(v4u*)(Gout + o0) = w0; if (has1) *(v4u*)(Gout + o1) = w1;
    }
}

typedef short s16x4 __attribute__((ext_vector_type(4)));
__device__ __forceinline__ bf16x8 tr_frag(LAS unsigned char* p0, LAS unsigned char* p1) {
    const s16x4 a = __builtin_amdgcn_ds_read_tr16_b64_v4i16((LAS s16x4*)p0), b = __builtin_amdgcn_ds_read_tr16_b64_v4i16((LAS s16x4*)p1);
    return __builtin_shufflevector(a, b, 0, 1, 2, 3, 4, 5, 6, 7);
}
__device__ __forceinline__ float fexp(float x) { return __builtin_amdgcn_exp2f(1.4426950408889634f * x); }
__device__ __forceinline__ int mlc_rowbase(int b, int dir, int cc) {
    if (cc < 4) { const int nc = dir ? 3 - cc : cc; return b * 256 + 64 * nc; }
    const int n0 = cc - 4, nc = dir ? 63 - n0 : n0; return NRC + b * 4096 + 64 * nc;
}
#define DPP_F(oldv, src, ctrl, rmask) __builtin_bit_cast(float, __builtin_amdgcn_update_dpp(__builtin_bit_cast(int, (float)(oldv)), __builtin_bit_cast(int, (float)(src)), (ctrl), (rmask), 0xf, false))
__device__ __forceinline__ float wave_scan_add(float x) {
    x += DPP_F(0.f, x, 0x111, 0xf); x += DPP_F(0.f, x, 0x112, 0xf); x += DPP_F(0.f, x, 0x114, 0xf); x += DPP_F(0.f, x, 0x118, 0xf);
    x += DPP_F(0.f, x, 0x142, 0xa); x += DPP_F(0.f, x, 0x143, 0xc); return x; }
__device__ __forceinline__ float wave_scan_max(float x) {
    const float NI = -__builtin_inff();
    x = fmaxf(x, DPP_F(NI, x, 0x111, 0xf)); x = fmaxf(x, DPP_F(NI, x, 0x112, 0xf)); x = fmaxf(x, DPP_F(NI, x, 0x114, 0xf)); x = fmaxf(x, DPP_F(NI, x, 0x118, 0xf));
    x = fmaxf(x, DPP_F(NI, x, 0x142, 0xa)); x = fmaxf(x, DPP_F(NI, x, 0x143, 0xc)); return x; }
__device__ __forceinline__ void phase_mlstm_chunk2(const Ctx& c, const bf16* Q, const bf16* K, const bf16* V, const float* GATES, bf16* HF, bf16* HB) {
    constexpr int QS = 0, KS = 17408, KWS = 34816  , VS = 69632  , PS = 87040, CB = 96256, NV = 113664, QN = 114176, GL = 114432  , NP = 115456  , PRIV = 119552;
    static_assert(PRIV + 8 * 1280 <= RING_BYTES && NP + 8 * 128 * 4 <= PRIV, "mLSTM chunk LDS map");
    LAS unsigned char* L = c.lds;
    const int tid = c.tid, lane = c.lane, w = c.wave, l15 = lane & 15, g4 = lane >> 4, qq = l15 >> 2, pp = l15 & 3;
    const int et = w & 3, ih = w >> 2;
    LAS float* priv = (LAS float*)(L + PRIV + w * 1280);
    const int srow = tid >> 3, spc = tid & 7;
    bf16x8 ones;
#pragma unroll
    for (int e = 0; e < 8; ++e) ones[e] = (short)0x3F80;
    for (int u = c.vcu; u < 256; u += c.G) {
        const int es = u & 3, dir = (u >> 2) & 1, h = (u >> 3) & 7, b = u >> 6;
        bf16* HOUT = dir ? HB : HF;
        __syncthreads();
        for (int i = tid; i < 17408 / 4; i += 512) ((LAS unsigned*)(L + CB))[i] = 0u;
        if (tid < 128) ((LAS float*)(L + NV))[tid] = 0.f;
        f32x4 Cacc[4];
#pragma unroll
        for (int j = 0; j < 4; ++j) Cacc[j] = (f32x4){0.f, 0.f, 0.f, 0.f};
        float m = 0.f;
        struct MlcRegs { v4u q0, q1, k0, k1, v; };
        MlcRegs RA, RB; float rg = 0.f;
        const int sgn64 = dir ? -64 : 64, dB = NRC + b * 3840 + (dir ? 4032 : -192);
        int lc = 0, gc = 0;
        const bf16 *qp, *kp, *vp; const float* gp; bf16* hp[2];
        { const size_t R0_ = (size_t)(mlc_rowbase(b, dir, 0) + (dir ? 63 - srow : srow)); qp = Q + R0_ * 1024 + h * 128 + spc * 16; kp = K + R0_ * 1024 + h * 128 + spc * 16; vp = V + R0_ * D + h * 256 + es * 64 + spc * 8;
          const int s_ = tid & 63, wh_ = (tid >> 6) & 1; gp = GATES + (size_t)(mlc_rowbase(b, dir, 0) + (dir ? 63 - s_ : s_)) * 32 + (2 * dir + wh_) * 8 + h;
#pragma unroll
          for (int t = 0; t < 2; ++t) { const int i = 16 * (2 * ih + t) + l15; hp[t] = HOUT + (size_t)(mlc_rowbase(b, dir, 0) + (dir ? 63 - i : i)) * D + h * 256 + es * 64 + 16 * et + 4 * g4; } }
#define MLC_LOAD(S_) do { S_.q0 = *(const v4u*)qp; S_.q1 = *(const v4u*)(qp + 8); S_.k0 = *(const v4u*)kp; S_.k1 = *(const v4u*)(kp + 8); S_.v = *(const v4u*)vp; \
            const long dr_ = (lc == 3) ? dB : sgn64; qp += dr_ * 1024; kp += dr_ * 1024; vp += dr_ * D; ++lc; } while (0)
#define MLC_LOADG(cc_) do { if (tid < 128) rg = *gp; const long dr_ = (gc == 3) ? dB : sgn64; gp += dr_ * 32; ++gc; } while (0)
#define MLC_STOREG(buf_) do { if (tid < 128) ((LAS float*)(L + GL + (buf_) * 512))[tid] = rg; } while (0)
        MLC_LOADG(0); MLC_STOREG(0); MLC_LOADG(1);
        MLC_LOAD(RA); MLC_LOAD(RB);
        __syncthreads();
        float decay = 0.f, wgr_n = 0.f; v4u ck0 = {0u, 0u, 0u, 0u}, ck1 = {0u, 0u, 0u, 0u};
        auto secA = [&](const int cn, MlcRegs& S) __attribute__((always_inline)) {
            const int db = cn & 1;
            LAS unsigned char* KWb = L + KWS + db * 17408; LAS unsigned char* Vb_ = L + VS + db * 8704;
            *(LAS v4u*)(L + QS + srow * 272 + spc * 32) = S.q0; *(LAS v4u*)(L + QS + srow * 272 + spc * 32 + 16) = S.q1;
            *(LAS v4u*)(L + KS + srow * 272 + spc * 32) = S.k0; *(LAS v4u*)(L + KS + srow * 272 + spc * 32 + 16) = S.k1;
            *(LAS v2u*)(Vb_ + srow * 136 + spc * 16) = (v2u){S.v.x, S.v.y}; *(LAS v2u*)(Vb_ + srow * 136 + spc * 16 + 8) = (v2u){S.v.z, S.v.w};
            ck0 = S.k0; ck1 = S.k1;
            MLC_STOREG(db ^ 1);
            if (cn + 2 < 68) MLC_LOAD(S);
            if (cn + 2 < 68) MLC_LOADG(cn + 2);
            { const float li = ((LAS float*)(L + GL + db * 512))[lane], lf = ((LAS float*)(L + GL + db * 512))[64 + lane];
                const float bc = wave_scan_add(lf);
                const float a = li - bc; const float pm = wave_scan_max(a);
                const float M = fmaxf(m, pm);
                const float M63 = __builtin_bit_cast(float, __builtin_amdgcn_readlane(__builtin_bit_cast(int, M), 63)), b63 = __builtin_bit_cast(float, __builtin_amdgcn_readlane(__builtin_bit_cast(int, bc), 63));
                priv[lane] = a; priv[64 + lane] = -M; priv[128 + lane] = fexp(m - M); priv[192 + lane] = fexp(-bc - M); priv[256 + lane] = fexp(a - M63);
                decay = fexp(m - M63); m = b63 + M63; }
            wgr_n = priv[256 + srow];
        };
        auto secA2 = [&](const int cn) __attribute__((always_inline)) {
            const int db = cn & 1;
            LAS unsigned char* KWb = L + KWS + db * 17408;
            { const float wgr = wgr_n;
                v4u k0, k1;
                k0.x = pg8::cvt_pk_bf16(bflo(ck0.x) * wgr, bfhi(ck0.x) * wgr); k0.y = pg8::cvt_pk_bf16(bflo(ck0.y) * wgr, bfhi(ck0.y) * wgr); k0.z = pg8::cvt_pk_bf16(bflo(ck0.z) * wgr, bfhi(ck0.z) * wgr); k0.w = pg8::cvt_pk_bf16(bflo(ck0.w) * wgr, bfhi(ck0.w) * wgr);
                k1.x = pg8::cvt_pk_bf16(bflo(ck1.x) * wgr, bfhi(ck1.x) * wgr); k1.y = pg8::cvt_pk_bf16(bflo(ck1.y) * wgr, bfhi(ck1.y) * wgr); k1.z = pg8::cvt_pk_bf16(bflo(ck1.z) * wgr, bfhi(ck1.z) * wgr); k1.w = pg8::cvt_pk_bf16(bflo(ck1.w) * wgr, bfhi(ck1.w) * wgr);
                *(LAS v4u*)(KWb + srow * 272 + spc * 32) = k0; *(LAS v4u*)(KWb + srow * 272 + spc * 32 + 16) = k1; }
        };
        secA(0, RA); secA2(0);
        __syncthreads();
        auto chunk_iter = [&](const int cc, MlcRegs& S) __attribute__((always_inline)) {
            const int db = cc & 1;
            LAS unsigned char* KWb = L + KWS + db * 17408; LAS unsigned char* Vb_ = L + VS + db * 8704;
            bf16x8 qf[2][4];
            f32x4 oacc[2];
            {
#pragma unroll
                for (int t = 0; t < 2; ++t)
#pragma unroll
                    for (int ks = 0; ks < 4; ++ks) qf[t][ks] = *(const LAS bf16x8*)(L + QS + (16 * (2 * ih + t) + l15) * 272 + ks * 64 + g4 * 16);
                f32x4 sacc[2] = {(f32x4){0.f, 0.f, 0.f, 0.f}, (f32x4){0.f, 0.f, 0.f, 0.f}};
#pragma unroll
                for (int ks = 0; ks < 4; ++ks) { const bf16x8 kf = *(const LAS bf16x8*)(L + KS + (16 * et + l15) * 272 + ks * 64 + g4 * 16);
                    sacc[0] = __builtin_amdgcn_mfma_f32_16x16x32_bf16(kf, qf[0][ks], sacc[0], 0, 0, 0); sacc[1] = __builtin_amdgcn_mfma_f32_16x16x32_bf16(kf, qf[1][ks], sacc[1], 0, 0, 0); }
                oacc[0] = (f32x4){0.f, 0.f, 0.f, 0.f}; oacc[1] = (f32x4){0.f, 0.f, 0.f, 0.f};
#pragma unroll
                for (int ks = 0; ks < 4; ++ks) { const bf16x8 cf = *(const LAS bf16x8*)(L + CB + (16 * et + l15) * 272 + ks * 64 + g4 * 16);
                    oacc[0] = __builtin_amdgcn_mfma_f32_16x16x32_bf16(cf, qf[0][ks], oacc[0], 0, 0, 0); oacc[1] = __builtin_amdgcn_mfma_f32_16x16x32_bf16(cf, qf[1][ks], oacc[1], 0, 0, 0); }
                const f32x4 av = *(const LAS f32x4*)(priv + 16 * et + 4 * g4);
#pragma unroll
                for (int t = 0; t < 2; ++t) { const int i = 16 * (2 * ih + t) + l15; const float negM = priv[64 + i]; float pv4[4];
#pragma unroll
                    for (int r = 0; r < 4; ++r) { const int s = 16 * et + 4 * g4 + r; const float wgt = (s <= i) ? fexp(av[r] + negM) : 0.f; pv4[r] = sacc[t][r] * wgt; }
                    *(LAS v2u*)(L + PS + i * 144 + (16 * et + 4 * g4) * 2) = (v2u){pg8::cvt_pk_bf16(pv4[0], pv4[1]), pg8::cvt_pk_bf16(pv4[2], pv4[3])};
                    oacc[t] = oacc[t] * priv[128 + i]; }
                { const v4u a0 = *(const LAS v4u*)(L + QS + srow * 272 + spc * 32), a1 = *(const LAS v4u*)(L + QS + srow * 272 + spc * 32 + 16);
                    const LAS f32x4* np = (const LAS f32x4*)(L + NV + spc * 64); const f32x4 n0 = np[0], n1 = np[1], n2 = np[2], n3 = np[3];
                    float d = bflo(a0.x) * n0[0] + bfhi(a0.x) * n0[1] + bflo(a0.y) * n0[2] + bfhi(a0.y) * n0[3] + bflo(a0.z) * n1[0] + bfhi(a0.z) * n1[1] + bflo(a0.w) * n1[2] + bfhi(a0.w) * n1[3]
                            + bflo(a1.x) * n2[0] + bfhi(a1.x) * n2[1] + bflo(a1.y) * n2[2] + bfhi(a1.y) * n2[3] + bflo(a1.z) * n3[0] + bfhi(a1.z) * n3[1] + bflo(a1.w) * n3[2] + bfhi(a1.w) * n3[3];
                    d += DPP_F(0.f, d, 0xB1, 0xf); d += DPP_F(0.f, d, 0x4E, 0xf); d += DPP_F(0.f, d, 0x141, 0xf);
                    if (spc == 0) ((LAS float*)(L + QN))[srow] = d; }
                if (tid < 256) { const int d4 = tid & 31, rg8 = tid >> 5; f32x4 sm = {0.f, 0.f, 0.f, 0.f};
#pragma unroll
                    for (int s = 0; s < 8; ++s) { const v2u kv = *(const LAS v2u*)(KWb + (8 * rg8 + s) * 272 + d4 * 8); sm[0] += bflo(kv.x); sm[1] += bfhi(kv.x); sm[2] += bflo(kv.y); sm[3] += bfhi(kv.y); }
                    *(LAS f32x4*)(L + NP + (rg8 * 128 + 4 * d4) * 4) = sm; }
            }
            __syncthreads();
            const float dec_c = decay;
            float e128[2], e192[2], qnv[2];
#pragma unroll
            for (int t = 0; t < 2; ++t) { const int i = 16 * (2 * ih + t) + l15; e128[t] = priv[128 + i]; e192[t] = priv[192 + i]; qnv[t] = ((LAS float*)(L + QN))[i]; }
            secA(cc + 1, S);
            {
                bf16x8 vf[2];
#pragma unroll
                for (int ks = 0; ks < 2; ++ks) { LAS unsigned char* vp = Vb_ + (32 * ks + 8 * g4 + qq) * 136 + (16 * et + 4 * pp) * 2; vf[ks] = tr_frag(vp, vp + 4 * 136); }
                f32x4 racc[2] = {(f32x4){0.f, 0.f, 0.f, 0.f}, (f32x4){0.f, 0.f, 0.f, 0.f}};
#pragma unroll
                for (int ks = 0; ks < 2; ++ks)
#pragma unroll
                    for (int t = 0; t < 2; ++t) { const bf16x8 pf = *(const LAS bf16x8*)(L + PS + (16 * (2 * ih + t) + l15) * 144 + ks * 64 + g4 * 16);
                        oacc[t] = __builtin_amdgcn_mfma_f32_16x16x32_bf16(vf[ks], pf, oacc[t], 0, 0, 0); racc[t] = __builtin_amdgcn_mfma_f32_16x16x32_bf16(ones, pf, racc[t], 0, 0, 0); }
#pragma unroll
                for (int t = 0; t < 2; ++t) { const int i = 16 * (2 * ih + t) + l15;
                    const float den = e128[t] * qnv[t] + racc[t][0];
                    const float inv = __builtin_amdgcn_rcpf(fmaxf(fabsf(den), e192[t]));
                    const f32x4 ho = oacc[t] * inv; *(v2u*)hp[t] = (v2u){pg8::cvt_pk_bf16(ho[0], ho[1]), pg8::cvt_pk_bf16(ho[2], ho[3])}; }
                { const long dr_ = (cc == 3) ? dB : sgn64; hp[0] += dr_ * D; hp[1] += dr_ * D; }
#pragma unroll
                for (int j = 0; j < 4; ++j) Cacc[j] = Cacc[j] * dec_c;
#pragma unroll
                for (int ks = 0; ks < 2; ++ks)
#pragma unroll
                    for (int j = 0; j < 4; ++j) { LAS unsigned char* kp = KWb + (32 * ks + 8 * g4 + qq) * 272 + (16 * (4 * ih + j) + 4 * pp) * 2; const bf16x8 kwf = tr_frag(kp, kp + 4 * 272);
                        Cacc[j] = __builtin_amdgcn_mfma_f32_16x16x32_bf16(kwf, vf[ks], Cacc[j], 0, 0, 0); }
#pragma unroll
                for (int j = 0; j < 4; ++j)
                    *(LAS v2u*)(L + CB + (16 * et + l15) * 272 + (16 * (4 * ih + j) + 4 * g4) * 2) = (v2u){pg8::cvt_pk_bf16(Cacc[j][0], Cacc[j][1]), pg8::cvt_pk_bf16(Cacc[j][2], Cacc[j][3])};
                if (tid < 128) { LAS float* np = (LAS float*)(L + NP) + tid; LAS float* nv = (LAS float*)(L + NV);
                    float x0 = np[0], x1 = np[128], x2 = np[256], x3 = np[384], x4 = np[512], x5 = np[640], x6 = np[768], x7 = np[896], x8 = nv[tid];
                    asm volatile("" : "+v"(x0), "+v"(x1), "+v"(x2), "+v"(x3), "+v"(x4), "+v"(x5), "+v"(x6), "+v"(x7), "+v"(x8));
                    nv[tid] = dec_c * x8 + (((x0 + x1) + (x2 + x3)) + ((x4 + x5) + (x6 + x7))); }
            }
            secA2(cc + 1);
            __syncthreads();
        };
        for (int cc = 0; cc < 68; cc += 2) { chunk_iter(cc, RB); chunk_iter(cc + 1, RA); }
#undef MLC_LOAD
#undef MLC_LOADG
#undef MLC_STOREG
    }
}

__device__ __forceinline__ void phase_ml_readout(const Ctx& c, const bf16* HF, const bf16* HB, const bf16* O, const float* nw, bf16* Gout, int r_lo) {
    const int gw = c.wave * c.G + c.vcu, NGW = c.G * NWAVES;
    struct RdRow { v2u hf[8], hb[8], o[8]; };
    f32x4 w4[8];
#pragma unroll
    for (int j = 0; j < 8; ++j) w4[j] = *(const f32x4*)(nw + 256 * j + 4 * c.lane);
    auto ld = [&](RdRow& w, const int R) __attribute__((always_inline)) { if (R < NR) {
#pragma unroll
        for (int j = 0; j < 8; ++j) { const size_t off = (size_t)R * D + 256 * j + 4 * c.lane; w.hf[j] = __builtin_nontemporal_load((const v2u*)(HF + off)); w.hb[j] = __builtin_nontemporal_load((const v2u*)(HB + off)); w.o[j] = __builtin_nontemporal_load((const v2u*)(O + off)); } } };
    auto proc = [&](const int R, const RdRow& w) __attribute__((always_inline)) {
        int dstR = R;
        if (R >= NRC) { const int q = R - NRC, pq = q & 4095; dstR = NRC + (q & ~4095) + ((pq & 63) << 6) + (pq >> 6); }
#pragma unroll
        for (int j = 0; j < 8; ++j) {
            const f32x4 hs = (f32x4){bflo(w.hf[j].x), bfhi(w.hf[j].x), bflo(w.hf[j].y), bfhi(w.hf[j].y)} + (f32x4){bflo(w.hb[j].x), bfhi(w.hb[j].x), bflo(w.hb[j].y), bfhi(w.hb[j].y)};
            const float ss = wave_sum((hs[0] * hs[0] + hs[1] * hs[1]) + (hs[2] * hs[2] + hs[3] * hs[3]));
            const float rs = __builtin_amdgcn_rsqf(ss * (1.0f / 256.0f) + EPSN);
            const float o0 = hs[0] * rs * w4[j][0] * fsigmoid(bflo(w.o[j].x)), o1 = hs[1] * rs * w4[j][1] * fsigmoid(bfhi(w.o[j].x)), o2 = hs[2] * rs * w4[j][2] * fsigmoid(bflo(w.o[j].y)), o3 = hs[3] * rs * w4[j][3] * fsigmoid(bfhi(w.o[j].y));
            v2u ow; ow.x = pk2(o0, o1); ow.y = pk2(o2, o3); *(v2u*)(Gout + (size_t)dstR * D + 256 * j + 4 * c.lane) = ow; }
    };
    RdRow wA, wB, wC;
    int R = r_lo + gw;
    ld(wA, R); ld(wB, R + NGW);
    while (R < NR) {
        ld(wC, R + 2 * NGW); proc(R, wA); R += NGW; if (R >= NR) break;
        ld(wA, R + 2 * NGW); proc(R, wB); R += NGW; if (R >= NR) break;
        ld(wB, R + 2 * NGW); proc(R, wC); R += NGW;
    }
}

struct Args { const float* in[24]; float* out; unsigned char* ws; int ph_lo, ph_hi; };
constexpr int NPHASES = 1 + 2 * 6 + 2 * 8 + 1;
typedef const float* fptr_t;
#ifndef PHSEL
#define PHSEL 0xffffffffu
#endif
__global__ void __launch_bounds__(NWAVES * 64, 2) mk_fwd(Args args) {
    extern __shared__ __attribute__((aligned(16))) unsigned char lds_raw[];
    LAS unsigned char* const lds = (LAS unsigned char*)lds_raw;
    int wave_s = __builtin_amdgcn_readfirstlane((int)threadIdx.x >> 6); asm volatile("" : "+s"(wave_s));
    { const int tid0 = wave_s * 64 + mk_lane();
      for (int u = tid0; u < (LDS_BYTES - LDSCTL_OFF) / 4; u += NWAVES * 64) ((LAS unsigned*)(lds + LDSCTL_OFF))[u] = 0u; }
    __syncthreads();
    volatile LAS unsigned* MISC = (volatile LAS unsigned*)(lds + MISC_OFF);
    XcdBarrier bar; bar.bar = (unsigned*)(args.ws + WS_CTL) + CW_BAR; bar.x = 0; bar.st = nullptr;
    if (MK_ONE_LAUNCH) bar = xcd_barrier_post((unsigned*)(args.ws + WS_CTL) + CW_BAR, MISC + 8, wave_s);
    const int lo = args.ph_lo, hi = args.ph_hi;
    int pc = 0;
#ifndef PROBE_DUP
#define PROBE_DUP 0u
#endif
#define PH_BEGIN(id) if (pc >= lo && pc < hi && (PHSEL & (1u << (id)))) for (int rep_ = ((PROBE_DUP & (1u << (id))) ? 1 : 0); rep_ >= 0; --rep_) { __syncthreads(); \
        const __attribute__((address_space(4))) fptr_t* inl = (const __attribute__((address_space(4))) fptr_t*)__builtin_amdgcn_kernarg_segment_ptr(); asm volatile("" : "+s"(inl)); \
        Ctx c; _Pragma("unroll") for (int i_ = 0; i_ < 24; ++i_) c.in[i_] = inl[i_]; c.ws = (unsigned char*)inl[25]; float* const outp = (float*)inl[24]; (void)outp; \
        int tid_ = wave_s * 64 + mk_lane(); asm volatile("" : "+v"(tid_)); int bx_ = blockIdx.x; asm volatile("" : "+s"(bx_)); int G_ = gridDim.x; asm volatile("" : "+s"(G_)); \
        c.lds = lds; c.tid = tid_; c.lane = c.tid & 63; c.wave = __builtin_amdgcn_readfirstlane(c.tid >> 6); \
        c.G = G_; c.bx = bx_; c.vcu = (c.G % 8 == 0) ? (bx_ % 8) * (c.G / 8) + bx_ / 8 : bx_; \
        bf16* const X = (bf16*)(c.ws + WS_X); bf16* const U = (bf16*)(c.ws + WS_U); bf16* const Gb = (bf16*)(c.ws + WS_G); bf16* const HID = (bf16*)(c.ws + WS_HID); \
        float* const TA0 = (float*)(c.ws + WS_TA); float* const TA1 = (float*)(c.ws + WS_TA + SZ_F32ROWS); \
        bf16* const Qb = (bf16*)(c.ws + WS_Q); bf16* const Kb = (bf16*)(c.ws + WS_K); bf16* const Vb = (bf16*)(c.ws + WS_V); bf16* const Ob = (bf16*)(c.ws + WS_O); float* const GATES = (float*)(c.ws + WS_GATES); \
        const int j = layer >> 1; const float* const modl = (const float*)(c.ws + WS_MOD) + (size_t)layer * 5 * 6 * D; \
        const void* const ctxsrc = layer == 0 ? (const void*)c.in[2] : (const void*)X; const void* const latsrc = layer == 0 ? (const void*)c.in[0] : (const void*)(X + (size_t)NRC * D); \
        (void)X; (void)U; (void)Gb; (void)HID; (void)TA0; (void)TA1; (void)Qb; (void)Kb; (void)Vb; (void)Ob; (void)GATES; (void)j; (void)modl; (void)ctxsrc; (void)latsrc;
#ifndef PROBE_XBAR
#define PROBE_XBAR 0
#endif
#define PH_END } if (MK_ONE_LAUNCH && pc >= lo && pc + 1 < hi) { xcd_barrier(bar, wave_s); if (PROBE_XBAR) xcd_barrier(bar, wave_s); } ++pc;

    int layer = 0;
    PH_BEGIN(0) phase_prologue(c); PH_END

    for (layer = 0; layer < DEPTH; ++layer) {
        if ((layer & 1) == 0) {
            PH_BEGIN(1) if (layer == 0) phase_norm<false, true>(c, ctxsrc, latsrc, c.in[6] + layer * D, modl, 0, 1, U, nullptr, X, 0); else phase_norm<false, false>(c, ctxsrc, latsrc, c.in[6] + layer * D, modl, 0, 1, U, rep_ ? nullptr : (const bf16*)TA0, X, 0); PH_END
            PH_BEGIN(2) phase_s5_scan3(c, j, U, (bf16*)TA0, (bf16*)TA1, c.in[16] + j * D, Gb); PH_END
            PH_BEGIN(4) { pg8::Gemm g{Gb, (const bf16*)(c.ws + WS_WGLU + j * SZ_WGLU), NR, 2 * D, D}; pg8::StaticOrder S; S.init(NR, 2 * D, c.G, c.bx, D);
                EpiGlu E{c.in[2], c.in[0], X, modl, 0, layer == 0}; pg8::gemm_phase<EpiGlu, pg8::StaticOrder, true, true>(c.lds, g, S, E, c.tid);
                if (rep_ == 0) tail_convert(c, (NR / 256) * (2 * D / 256), layer == 0 ? TAIL_GLU0_LO : TAIL_GLU2_LO, layer == 0 ? TAIL_GLU0_HI : TAIL_GLU2_HI); } PH_END
        } else {
            PH_BEGIN(5) phase_norm<true, false>(c, ctxsrc, latsrc, c.in[6] + layer * D, modl, 0, 1, U, rep_ ? nullptr : (const bf16*)TA0, X, 0); PH_END
            PH_BEGIN(6) { pg8::Gemm g{U, (const bf16*)(c.ws + WS_WMLI + j * SZ_WMLI), NR, MLINP, D}; pg8::StaticOrder S; S.init(NR, MLINP, c.G, c.bx, D);
                EpiMli E{Qb, Kb, Vb, Ob, GATES, c.in[19] + j * 32}; pg8::gemm_phase<EpiMli, pg8::StaticOrder, true, true>(c.lds, g, S, E, c.tid);
                if (rep_ == 0) tail_convert(c, (NR / 256) * (MLINP / 256), layer == 1 ? TAIL_MLI1_LO : TAIL_MLI3_LO, layer == 1 ? TAIL_MLI1_HI : TAIL_MLI3_HI); } PH_END
            PH_BEGIN(7) phase_mlstm_chunk2(c, Qb, Kb, Vb, GATES, (bf16*)TA0, (bf16*)TA1); PH_END
            PH_BEGIN(8) phase_ml_readout(c, (const bf16*)TA0, (const bf16*)TA1, Ob, c.in[20] + j * D, Gb, layer == 3 ? NRC : 0); PH_END
            PH_BEGIN(9) { pg8::Gemm g{Gb, (const bf16*)(c.ws + WS_WMLO + j * SZ_WMLO), NR, D, D}; ResCtxOrder S; S.init(c.G, c.bx, D, layer == 1, 4, 8);
                EpiResSlab E{X, (bf16*)TA0, modl, 2}; pg8::gemm_phase<EpiResSlab, ResCtxOrder, true, true>(c.lds, g, S, E, c.tid); } PH_END
        }
        PH_BEGIN(10) phase_norm<false, false>(c, X, X + (size_t)NRC * D, c.in[7] + layer * D, modl, 3, 4, U, (layer == 1 && rep_ == 0) ? (const bf16*)TA0 : nullptr, X, layer == 3 ? NRC : 0); PH_END
        PH_BEGIN(11) { const int pm0 = layer == 3 ? 4 : 0; pg8::Gemm g{U + (size_t)pm0 * 256 * D, (const bf16*)(c.ws + WS_WFFI + layer * SZ_WFFI), NR - pm0 * 256, 2 * FF, D}; pg8::StaticOrder S; S.init(NR - pm0 * 256, 2 * FF, c.G, c.bx, D);
            EpiFfi E{HID, pm0}; pg8::gemm_phase<EpiFfi, pg8::StaticOrder, true, true>(c.lds, g, S, E, c.tid);
            if (rep_ == 0 && layer < 3) tail_convert(c, (NR / 256) * (2 * FF / 256), layer == 0 ? TAIL_FFI0_LO : (layer == 1 ? TAIL_FFI1_LO : TAIL_FFI2_LO), layer == 0 ? TAIL_FFI0_HI : (layer == 1 ? TAIL_FFI1_HI : TAIL_FFI2_HI)); } PH_END
        PH_BEGIN(12) { pg8::Gemm g{HID, (const bf16*)(c.ws + WS_WFFO + layer * SZ_WFFO), NR, D, FF}; ResCtxOrder S; S.init(c.G, c.bx, FF, layer < 3, 12, 4);
            EpiResSlab E{X, (bf16*)TA0, modl, 5}; pg8::gemm_phase<EpiResSlab, ResCtxOrder, true, true>(c.lds, g, S, E, c.tid); } PH_END
    }
    layer = 0;
    PH_BEGIN(13) phase_final(c, X, c.in[8], outp); PH_END
#undef PH_BEGIN
#undef PH_END
}

extern "C" void kernel_launch(void* const* d_in, const int* in_sizes, int n_in, void* d_out, int out_size, void* d_ws, size_t ws_size, hipStream_t stream) {
    static int grid = 0;
    if (grid == 0) {
        if (n_in != 24 || in_sizes[0] != NRL * D || out_size != NRL * D || ws_size < WS_END) { fprintf(stderr, "kernel_launch: unexpected shapes (n_in %d, in0 %d, out %d, ws %zu < %zu); nothing launched\n", n_in, n_in > 0 ? in_sizes[0] : -1, out_size, ws_size, (size_t)WS_END); grid = -1; return; }
        int dev = 0, cus = 0, per_cu = 0;
        if (hipGetDevice(&dev) != hipSuccess || hipDeviceGetAttribute(&cus, hipDeviceAttributeMultiprocessorCount, dev) != hipSuccess) { grid = -1; return; }
        if (hipFuncSetAttribute((const void*)mk_fwd, hipFuncAttributeMaxDynamicSharedMemorySize, LDS_BYTES) != hipSuccess) { fprintf(stderr, "kernel_launch: hipFuncSetAttribute failed\n"); grid = -1; return; }
        if (hipOccupancyMaxActiveBlocksPerMultiprocessor(&per_cu, (const void*)mk_fwd, NWAVES * 64, LDS_BYTES) != hipSuccess || per_cu < 1)
            fprintf(stderr, "kernel_launch: occupancy query reports %d workgroups per CU\n", per_cu);
        (void)hipGetLastError();
        grid = cus;
    }
    if (grid < 0) return;
    if (hipMemsetAsync((char*)d_ws + WS_CTL, 0, CTL_ZERO_BYTES, stream) != hipSuccess) return;
    Args a{};
    for (int i = 0; i < 24; ++i) a.in[i] = (const float*)d_in[i];
    a.out = (float*)d_out; a.ws = (unsigned char*)d_ws;
#if MK_ONE_LAUNCH
    a.ph_lo = 0; a.ph_hi = NPHASES;
    hipLaunchKernelGGL(mk_fwd, dim3(grid), dim3(NWAVES * 64), LDS_BYTES, stream, a);
#else
    for (int ph = 0; ph < NPHASES; ++ph) { a.ph_lo = ph; a.ph_hi = ph + 1; hipLaunchKernelGGL(mk_fwd, dim3(grid), dim3(NWAVES * 64), LDS_BYTES, stream, a); }
#endif
}
```
